# Optimizing an MI355X kernel written in HIP

```python
import math
import numpy as np
import jax, jax.numpy as jnp
from jax import lax

D_MODEL = 1024
BATCH = 8
SEQ = 4096
DEPTH = 2

HEAD_DIM = 64
ATTN_Q_HEADS = 8
ATTN_KV_HEADS = 2
ATTN_GROUP = ATTN_Q_HEADS // ATTN_KV_HEADS
ATTN_WIDTH = ATTN_Q_HEADS * HEAD_DIM
KV_WIDTH = ATTN_KV_HEADS * HEAD_DIM
WINDOW = 128
BLOCK = 128
N_BUCKETS = 32
MAX_DISTANCE = 128
RW_HEADS = 8
RW_HEAD = 64
RW_WIDTH = RW_HEADS * RW_HEAD
DECAY_RANK = 64
A_RANK = 64
V_RANK = 32
G_RANK = 128
GN_EPS = 64e-5
D_FF = 2816
ALPHA = (2 * DEPTH) ** 0.25
BETA = (8 * DEPTH) ** -0.25
LN_EPS = 1e-5

OFF_GATE_A = 0
OFF_GATE_B = D_MODEL
OFF_Q = 2 * D_MODEL
OFF_K = OFF_Q + ATTN_WIDTH
OFF_V = OFF_K + KV_WIDTH
OFF_RW = OFF_V + KV_WIDTH
RW_COLS = 3 * RW_WIDTH + DECAY_RANK + A_RANK + G_RANK
PROJ_WIDTH = OFF_RW + RW_COLS

kernel_name = 'hybrid_swa_rwkv7_macaron_deepnorm'


def layer_norm(x, g, b, eps=LN_EPS):
    xf = x.astype(jnp.float32)
    mu = jnp.mean(xf, axis=-1, keepdims=True)
    var = jnp.mean(jnp.square(xf - mu), axis=-1, keepdims=True)
    return ((xf - mu) * lax.rsqrt(var + eps) * g + b).astype(x.dtype)


def swiglu(x, w_gu, w_down):
    gate, up = jnp.split(x @ w_gu, 2, axis=-1)
    return (jax.nn.silu(gate) * up) @ w_down


def t5_bucket(n):
    max_exact = N_BUCKETS // 2
    nf = jnp.maximum(n, 1).astype(jnp.float32)
    large = max_exact + (jnp.log(nf / max_exact) / math.log(MAX_DISTANCE / max_exact)
                         * (N_BUCKETS - max_exact)).astype(jnp.int32)
    large = jnp.minimum(large, N_BUCKETS - 1)
    return jnp.where(n < max_exact, n, large)


def sliding_window_attention(q, k, v, dist_bias, sinks):
    b_, s_, _ = q.shape
    nb = s_ // BLOCK
    qb = q.reshape(b_, nb, BLOCK, ATTN_KV_HEADS, ATTN_GROUP, HEAD_DIM)

    def band(t):
        tb = t.reshape(b_, nb, BLOCK, ATTN_KV_HEADS, HEAD_DIM)
        prev = jnp.pad(tb, ((0, 0), (1, 0), (0, 0), (0, 0), (0, 0)))[:, :-1]
        return jnp.concatenate([prev, tb], axis=2)

    kb, vb = band(k), band(v)
    s = jnp.einsum('bnqhgd,bnkhd->bnhgqk', qb, kb).astype(jnp.float32) * (HEAD_DIM ** -0.5)
    qi = np.arange(BLOCK)[:, None]
    kj = np.arange(2 * BLOCK)[None, :]
    dist = qi + BLOCK - kj
    local = (dist >= 0) & (dist < WINDOW)
    first = (np.arange(nb)[:, None, None] > 0) | (kj[None] >= BLOCK)
    mask = local[None] & first
    bias = dist_bias[:, np.clip(dist, 0, WINDOW - 1)].astype(jnp.float32)
    bias = bias.reshape(ATTN_KV_HEADS, ATTN_GROUP, BLOCK, 2 * BLOCK)
    s = jnp.where(mask[None, :, None, None], s + bias, -jnp.inf)
    sink = sinks.astype(jnp.float32).reshape(ATTN_KV_HEADS, ATTN_GROUP, 1, 1)
    m = jnp.maximum(jnp.max(s, axis=-1, keepdims=True), sink)
    p = jnp.exp(s - m)
    p = p / (jnp.sum(p, axis=-1, keepdims=True) + jnp.exp(sink - m))
    o = jnp.einsum('bnhgqk,bnkhd->bnqhgd', p.astype(v.dtype), vb)
    return o.reshape(b_, s_, ATTN_WIDTH)


def wkv7_scan(r, decay, k, v, a, b):
    def step(state, inp):
        r_t, w_t, k_t, v_t, a_t, b_t = inp
        sa = jnp.einsum('bhij,bhj->bhi', state, a_t)
        state = (state * w_t[:, :, None, :] + sa[..., None] * b_t[:, :, None, :]
                 + v_t[..., None] * k_t[:, :, None, :])
        return state, jnp.einsum('bhij,bhj->bhi', state, r_t)

    xs = tuple(jnp.moveaxis(t.astype(jnp.float32), 1, 0) for t in (r, decay, k, v, a, b))
    b_, _, h_, n_ = r.shape
    s0 = jnp.zeros((b_, h_, n_, n_), jnp.float32)
    _, y = lax.scan(step, s0, xs)
    return jnp.moveaxis(y, 0, 1)


def rwkv7_mix(u, w0, w2, a0, a2, g2, k_k, k_a, r_k, gn_g, gn_b, v_first, vmix):
    b_, s_, _ = u.shape
    c = RW_WIDTH
    r = u[..., :c]
    k = u[..., c:2 * c]
    v = u[..., 2 * c:3 * c]
    o = 3 * c
    xw = u[..., o:o + DECAY_RANK]
    xa = u[..., o + DECAY_RANK:o + DECAY_RANK + A_RANK]
    xg = u[..., o + DECAY_RANK + A_RANK:]
    w = -jax.nn.softplus(-(w0 + jnp.tanh(xw) @ w2)) - 0.5
    decay = jnp.exp(-jnp.exp(w.astype(jnp.float32)))
    a = jax.nn.sigmoid(a0 + xa @ a2)
    g = jax.nn.sigmoid(xg) @ g2
    if vmix is None:
        v_first = v
    else:
        v0, v1, v2 = vmix
        v = v + (v_first - v) * jax.nn.sigmoid(v0 + (v @ v1) @ v2)
    heads = lambda t: t.reshape(b_, s_, RW_HEADS, RW_HEAD)
    kk = heads(k * k_k).astype(jnp.float32)
    kk = kk / jnp.maximum(jnp.sqrt(jnp.sum(kk * kk, axis=-1, keepdims=True)), 1e-12)
    k = k * (1.0 + (a - 1.0) * k_a)
    rh, kh, vh, ah = heads(r), heads(k), heads(v), heads(a)
    y = wkv7_scan(rh, heads(decay), kh, vh, -kk, kk * ah)
    mu = jnp.mean(y, axis=-1, keepdims=True)
    var = jnp.mean(jnp.square(y - mu), axis=-1, keepdims=True)
    y = ((y - mu) * lax.rsqrt(var + GN_EPS)).reshape(b_, s_, c) * gn_g + gn_b
    bonus = jnp.sum(rh * kh * r_k, axis=-1, keepdims=True) * vh
    y = y + bonus.reshape(b_, s_, c)
    return y * g, v_first


def token_mix(x, w_in, b_in, mu, sinks, dist_bias, w0, w2, a0, a2, g2, k_k, k_a, r_k,
              gn_g, gn_b, w_ba, w_bb, w_o, v_first, vmix):
    proj = x @ w_in + b_in
    gate_a = jax.nn.sigmoid(proj[..., OFF_GATE_A:OFF_GATE_B])
    gate_b = jax.nn.sigmoid(proj[..., OFF_GATE_B:OFF_Q])
    attn = sliding_window_attention(proj[..., OFF_Q:OFF_K], proj[..., OFF_K:OFF_V],
                                    proj[..., OFF_V:OFF_RW], dist_bias, sinks)
    u = proj[..., OFF_RW:]
    u_prev = jnp.pad(u, ((0, 0), (1, 0), (0, 0)))[:, :-1]
    u = u + (u_prev - u) * mu
    rw, v_first = rwkv7_mix(u, w0, w2, a0, a2, g2, k_k, k_a, r_k, gn_g, gn_b, v_first, vmix)
    merged = gate_a * (attn @ w_ba) + gate_b * (rw @ w_bb)
    return merged @ w_o, v_first


def setup_inputs(seed: int = 0) -> dict:
    key = jax.random.key(seed)
    ks = jax.random.split(key, 26)
    nrm = lambda k, shape, scale: jax.random.normal(k, shape, jnp.float32) * scale
    L = DEPTH
    c = RW_WIDTH
    return {
        'x': nrm(ks[0], (BATCH, SEQ, D_MODEL), 1.0),
        'ffn_w_gu': nrm(ks[1], (L, 2, D_MODEL, 2 * D_FF), D_MODEL ** -0.5),
        'ffn_w_down': nrm(ks[2], (L, 2, D_FF, D_MODEL), BETA * D_FF ** -0.5),
        'ln_g': 1.0 + nrm(ks[3], (L, 3, D_MODEL), 0.02),
        'ln_b': nrm(ks[4], (L, 3, D_MODEL), 0.02),
        'w_in': nrm(ks[5], (L, D_MODEL, PROJ_WIDTH), D_MODEL ** -0.5),
        'b_in': nrm(ks[6], (L, PROJ_WIDTH), 0.02),
        'rel_bias': nrm(ks[7], (N_BUCKETS, ATTN_Q_HEADS), 0.5),
        'attn_sinks': nrm(ks[8], (L, ATTN_Q_HEADS), 0.5),
        'shift_mu': jax.random.uniform(ks[9], (L, RW_COLS), jnp.float32),
        'rw_w0': jax.random.uniform(ks[10], (L, c), jnp.float32, -6.0, 1.0),
        'rw_w2': nrm(ks[11], (L, DECAY_RANK, c), 0.5 * DECAY_RANK ** -0.5),
        'rw_a0': nrm(ks[12], (L, c), 0.1),
        'rw_a2': nrm(ks[13], (L, A_RANK, c), 0.5 * A_RANK ** -0.5),
        'rw_g2': nrm(ks[14], (L, G_RANK, c), G_RANK ** -0.5),
        'rw_k_k': 0.85 + nrm(ks[15], (L, c), 0.02),
        'rw_k_a': 1.0 + nrm(ks[16], (L, c), 0.02),
        'rw_r_k': nrm(ks[17], (L, RW_HEADS, RW_HEAD), 0.1),
        'rw_gn_g': 1.0 + nrm(ks[18], (L, c), 0.02),
        'rw_gn_b': nrm(ks[19], (L, c), 0.02),
        'rw_v0': nrm(ks[20], (L - 1, c), 0.1),
        'rw_v1': nrm(ks[21], (L - 1, c, V_RANK), c ** -0.5),
        'rw_v2': nrm(ks[22], (L - 1, V_RANK, c), 0.5 * V_RANK ** -0.5),
        'w_branch_attn': nrm(ks[23], (L, ATTN_WIDTH, D_MODEL), BETA * ATTN_WIDTH ** -0.5),
        'w_branch_rwkv': nrm(ks[24], (L, c, D_MODEL), BETA * c ** -0.5),
        'w_out': nrm(ks[25], (L, D_MODEL, D_MODEL), BETA * D_MODEL ** -0.5),
    }


def reference(x, ffn_w_gu, ffn_w_down, ln_g, ln_b, w_in, b_in, rel_bias, attn_sinks,
              shift_mu, rw_w0, rw_w2, rw_a0, rw_a2, rw_g2, rw_k_k, rw_k_a, rw_r_k,
              rw_gn_g, rw_gn_b, rw_v0, rw_v1, rw_v2, w_branch_attn, w_branch_rwkv, w_out):
    dist_bias = rel_bias[t5_bucket(jnp.arange(WINDOW, dtype=jnp.int32))].T
    v_first = None
    for l in range(DEPTH):
        x = layer_norm(ALPHA * x + 0.5 * swiglu(x, ffn_w_gu[l, 0], ffn_w_down[l, 0]),
                       ln_g[l, 0], ln_b[l, 0])
        vmix = None if l == 0 else (rw_v0[l - 1], rw_v1[l - 1], rw_v2[l - 1])
        mix, v_first = token_mix(x, w_in[l], b_in[l], shift_mu[l], attn_sinks[l], dist_bias,
                                 rw_w0[l], rw_w2[l], rw_a0[l], rw_a2[l], rw_g2[l],
                                 rw_k_k[l], rw_k_a[l], rw_r_k[l], rw_gn_g[l], rw_gn_b[l],
                                 w_branch_attn[l], w_branch_rwkv[l], w_out[l], v_first, vmix)
        x = layer_norm(ALPHA * x + mix, ln_g[l, 1], ln_b[l, 1])
        x = layer_norm(ALPHA * x + 0.5 * swiglu(x, ffn_w_gu[l, 1], ffn_w_down[l, 1]),
                       ln_g[l, 2], ln_b[l, 2])
    return x
```

```cpp
#include <hip/hip_runtime.h>
#include <hip/hip_cooperative_groups.h>
#include <math.h>
namespace cg = cooperative_groups;

#define LAS __attribute__((address_space(3)))
typedef unsigned short bf16_t;
typedef short bf16x8 __attribute__((ext_vector_type(8)));
typedef float f32x4 __attribute__((ext_vector_type(4)));
typedef unsigned u32x4 __attribute__((ext_vector_type(4)));
typedef unsigned u32x2 __attribute__((ext_vector_type(2)));

constexpr int M_TOK = 32768, SEQ = 4096;
constexpr float ALPHA = 1.41421356237f;
constexpr int LDS_XB = 153600;
constexpr int LDS_BYTES = LDS_XB + 16;

constexpr size_t MiB = 1u << 20;
constexpr size_t WS_WB = 0, WS_XB = 48 * MiB, WS_VF = 112 * MiB, WS_R = 144 * MiB, WS_END = 512 * MiB, WS_BAR = 47 * MiB + 512 * 1024;
constexpr size_t R_HB = 0, R_QKV = 0, R_U = 48 * MiB, R_VNEW = 48 * MiB, R_Y = 80 * MiB, R_ATT = 112 * MiB, R_CB = 144 * MiB,
                 R_R = 160 * MiB, R_K = 192 * MiB, R_V = 224 * MiB, R_AP = 256 * MiB, R_EW = 272 * MiB, R_A = 304 * MiB, R_G = 336 * MiB,
                 R_DEL = 176 * MiB, R_GA = 160 * MiB, R_GB = 256 * MiB, R_MB = 0;
constexpr size_t WB_GU0 = 0, WB_GU1 = 5767168, WB_D0 = 11534336, WB_D1 = 14417920, WB_IN = 17301504, WB_BA = 22020096, WB_BB = 22544384,
                 WB_O = 23068672, WB_LR = 24117248, WB_V12 = 24510464;

struct Params {
    const float* in[26];
    float* out;
    unsigned char* ws;
};

typedef __bf16 bf16x2_t __attribute__((ext_vector_type(2)));
typedef float f32x2_t __attribute__((ext_vector_type(2)));
__device__ __forceinline__ unsigned pk_bf16(float lo, float hi) { const f32x2_t f = {lo, hi}; return __builtin_bit_cast(unsigned, __builtin_convertvector(f, bf16x2_t)); }
__device__ __forceinline__ float bf_lo(unsigned w) { return __uint_as_float(w << 16); }
__device__ __forceinline__ float bf_hi(unsigned w) { return __uint_as_float(w & 0xffff0000u); }
__device__ __forceinline__ float bf2f(bf16_t b) { return __uint_as_float(((unsigned)b) << 16); }
__device__ __forceinline__ float sigm(float x) { return __builtin_amdgcn_rcpf(1.f + __expf(-x)); }
__device__ __forceinline__ int otid() { int t = threadIdx.x; asm volatile("" : "+v"(t)); return t; }
__device__ __forceinline__ int obid() { int b = blockIdx.x; asm volatile("" : "+s"(b)); return b; }
__device__ __forceinline__ float wave_sum(float x) {
#pragma unroll
    for (int o = 32; o >= 1; o >>= 1) x += __shfl_xor(x, o);
    return x;
}
template <int CTRL> __device__ __forceinline__ float dpp_f(float x) { return __builtin_bit_cast(float, __builtin_amdgcn_mov_dpp(__builtin_bit_cast(int, x), CTRL, 0xF, 0xF, true)); }
__device__ __forceinline__ float row16_sum(float x) {
    x += dpp_f<0xB1>(x); x += dpp_f<0x4E>(x); x += dpp_f<0x141>(x); x += dpp_f<0x140>(x); return x;
}
__device__ __forceinline__ float row16_max(float x) {
    x = fmaxf(x, dpp_f<0xB1>(x)); x = fmaxf(x, dpp_f<0x4E>(x)); x = fmaxf(x, dpp_f<0x141>(x)); x = fmaxf(x, dpp_f<0x140>(x)); return x;
}

constexpr int BM = 256, BK = 64, HALF = 128, HTB = HALF * BK * 2, NXCD = 8, WGM = 8;
__device__ __forceinline__ int lds_byte(int r, int c) { const int st = (r >> 4) * 2 + (c >> 5), rr = r & 15, cc = c & 31, ob = rr * 64 + cc * 2; return st * 1024 + (ob ^ (((ob >> 9) & 1) << 5)); }
__device__ __forceinline__ void stage_rc(int b, int& R, int& C) { const int st = b / 1024, sb = b % 1024, swz = sb ^ (((sb >> 9) & 1) << 5); R = (st >> 1) * 16 + swz / 64; C = (st & 1) * 32 + (swz % 64) / 2; }
__device__ __forceinline__ int perm32(int rho) { const int n = rho >> 4, i = rho & 15; return 8 * (i >> 2) + 4 * n + (i & 3); }

struct Unit { int pm, pn; };
struct Gemm { const bf16_t* A; const bf16_t* Bt; int M, N, K; };
struct StaticOrder {
    int nM, nN, nwg, G, c;
    __device__ void init(int M, int N, int G_, int c_) { nM = M / BM; nN = N / BM; nwg = nM * nN; G = G_; c = c_; }
    __device__ bool next(int i, Unit& u) const {
        const long L = (long)i * G + c; if (L >= nwg) return false;
        int wgid = (int)L; { const int q = nwg / NXCD, r = nwg % NXCD, xcd = wgid % NXCD, off = wgid / NXCD; wgid = (xcd < r ? xcd * (q + 1) : r * (q + 1) + (xcd - r) * q) + off; }
        const int nig = WGM * nN, gid = wgid / nig, fm = gid * WGM, gsz = (nM - fm) < WGM ? (nM - fm) : WGM;
        u.pm = fm + ((wgid % nig) % gsz); u.pn = (wgid % nig) / gsz; return true;
    }
};

template <class Epi>
__device__ __forceinline__ void gemm_phase(LAS unsigned char* lds, const Gemm g, const Epi& E) {
    const int tid = otid(), wid = __builtin_amdgcn_readfirstlane(tid >> 6), lane = tid & 63, wr = wid >> 2, wc = wid & 3, fr = lane & 15, fq = lane >> 4;
    int Kop = g.K; asm volatile("" : "+s"(Kop));
    const int K = Kop, nt = K / BK;
    StaticOrder S; S.init(g.M, g.N, (int)gridDim.x, obid());
    unsigned voffA[2], voffB[2];
#pragma unroll
    for (int i = 0; i < 2; ++i) { int R, C; stage_rc(tid * 16 + i * 8192, R, C); const int Rb = Epi::PERM ? ((R & ~31) + perm32(R & 31)) : R;
        voffA[i] = (unsigned)(R * K + C) * 2u; voffB[i] = (unsigned)(Rb * K + C) * 2u; }
    const size_t kstep = (size_t)(BK * 2);
    const size_t hstep = (size_t)HALF * K * 2;
    const size_t tstep = 2 * hstep;
    const unsigned ldsw = (unsigned)wid * 1024u;
    const int aoff = lds_byte(wr * 64 + fr, fq * 8), boff = lds_byte(wc * 32 + fr, fq * 8);
#define PG8_SA(b, h) (((b) * 2 + (h)) * HTB)
#define PG8_SB(b, h) ((4 + (b) * 2 + (h)) * HTB)
#define PG8_STAGE(bufoff, gbase, voff) do { _Pragma("unroll") for (int _i = 0; _i < 2; ++_i) \
        __builtin_amdgcn_global_load_lds((const unsigned*)((const char*)(gbase) + (voff)[_i]), (LAS unsigned*)(lds + (bufoff) + ldsw + _i * 8192), 16, 0, 0); } while (0)
#define PG8_LDA(dst, b, h) do { _Pragma("unroll") for (int m = 0; m < 4; ++m) _Pragma("unroll") for (int k = 0; k < 2; ++k) dst[m][k] = *(const LAS bf16x8*)(lds + PG8_SA(b, h) + aoff + m * 2048 + k * 1024); } while (0)
#define PG8_LDB(dst, b, h) do { _Pragma("unroll") for (int n = 0; n < 2; ++n) _Pragma("unroll") for (int k = 0; k < 2; ++k) dst[n][k] = *(const LAS bf16x8*)(lds + PG8_SB(b, h) + boff + n * 2048 + k * 1024); } while (0)
#define PG8_MMA(ai, bj, At, Bt) do { __builtin_amdgcn_s_setprio(1); _Pragma("unroll") for (int m = 0; m < 4; ++m) _Pragma("unroll") for (int n = 0; n < 2; ++n) _Pragma("unroll") for (int k = 0; k < 2; ++k) \
        acc[ai][bj][m][n] = __builtin_amdgcn_mfma_f32_16x16x32_bf16(Bt[n][k], At[m][k], acc[ai][bj][m][n], 0, 0, 0); __builtin_amdgcn_s_setprio(0); } while (0)
#define PG8_WAIT_V(n) asm volatile("s_waitcnt vmcnt(" #n ")" ::: "memory")
#define PG8_WAIT_L(n) asm volatile("s_waitcnt lgkmcnt(" #n ")" ::: "memory")
#define PG8_BAR __builtin_amdgcn_s_barrier()
#define PG8_SCHED __builtin_amdgcn_sched_barrier(0)
    Unit cur, nxt; int ui = 0;
    if (!S.next(0, cur)) return;
    f32x4 acc[2][2][4][2];
#pragma unroll
    for (int a = 0; a < 2; ++a)
#pragma unroll
        for (int b = 0; b < 2; ++b)
#pragma unroll
            for (int m = 0; m < 4; ++m)
#pragma unroll
                for (int n = 0; n < 2; ++n) acc[a][b][m][n] = (f32x4){0.f, 0.f, 0.f, 0.f};
    bf16x8 At[4][2], B0[2][2], B1[2][2];
    const char* cA = (const char*)g.A + (size_t)cur.pm * tstep; const char* cB = (const char*)g.Bt + (size_t)cur.pn * tstep;
    PG8_STAGE(PG8_SB(0, 0), cB, voffB); PG8_STAGE(PG8_SA(0, 0), cA, voffA); PG8_STAGE(PG8_SB(0, 1), cB + hstep, voffB); PG8_STAGE(PG8_SA(0, 1), cA + hstep, voffA);
    if (wr == 1) PG8_BAR;
    PG8_WAIT_V(4); PG8_BAR;
    PG8_STAGE(PG8_SB(1, 0), cB + kstep, voffB); PG8_STAGE(PG8_SA(1, 0), cA + kstep, voffA); PG8_STAGE(PG8_SB(1, 1), cB + hstep + kstep, voffB);
    PG8_WAIT_V(6); PG8_BAR;
    for (;;) {
        const bool has_next = S.next(ui + 1, nxt);
        const char* nA = has_next ? (const char*)g.A + (size_t)nxt.pm * tstep : cA; const char* nB = has_next ? (const char*)g.Bt + (size_t)nxt.pn * tstep : cB;
#pragma unroll 1
        for (int t = 0; t < nt; t += 2) {
            const bool last = (t == nt - 2);
            const char* a1 = cA + (size_t)(t + 1) * kstep;
            const char* a2 = last ? nA : cA + (size_t)(t + 2) * kstep; const char* b2 = last ? nB : cB + (size_t)(t + 2) * kstep;
            const char* a3 = a2 + kstep; const char* b3 = b2 + kstep;
            PG8_LDB(B0, 0, 0); PG8_SCHED; PG8_LDA(At, 0, 0); PG8_STAGE(PG8_SA(1, 1), a1 + hstep, voffA);
            PG8_WAIT_L(8); PG8_BAR; PG8_WAIT_L(0); PG8_MMA(0, 0, At, B0); PG8_BAR; PG8_SCHED;
            PG8_LDB(B1, 0, 1); PG8_STAGE(PG8_SB(0, 0), b2, voffB);
            PG8_BAR; PG8_WAIT_L(0); PG8_MMA(0, 1, At, B1); PG8_BAR;
            PG8_LDA(At, 0, 1); PG8_STAGE(PG8_SA(0, 0), a2, voffA);
            PG8_BAR; PG8_WAIT_L(0); PG8_MMA(1, 0, At, B0); PG8_BAR; PG8_SCHED;
            PG8_STAGE(PG8_SB(0, 1), b2 + hstep, voffB);
            PG8_WAIT_V(6); PG8_BAR; PG8_MMA(1, 1, At, B1); PG8_BAR;
            PG8_LDB(B0, 1, 0); PG8_SCHED; PG8_LDA(At, 1, 0); PG8_STAGE(PG8_SA(0, 1), a2 + hstep, voffA);
            PG8_WAIT_L(8); PG8_BAR; PG8_WAIT_L(0); PG8_MMA(0, 0, At, B0); PG8_BAR; PG8_SCHED;
            PG8_LDB(B1, 1, 1); PG8_STAGE(PG8_SB(1, 0), b3, voffB);
            PG8_BAR; PG8_WAIT_L(0); PG8_MMA(0, 1, At, B1); PG8_BAR;
            PG8_LDA(At, 1, 1); PG8_STAGE(PG8_SA(1, 0), a3, voffA);
            PG8_BAR; PG8_WAIT_L(0); PG8_MMA(1, 0, At, B0); PG8_BAR; PG8_SCHED;
            PG8_STAGE(PG8_SB(1, 1), b3 + hstep, voffB);
            PG8_WAIT_V(6); PG8_BAR; PG8_MMA(1, 1, At, B1); PG8_BAR;
        }
        { int fr2 = fr, fq2 = fq; asm volatile("" : "+v"(fr2), "+v"(fq2)); E(acc, cur, wr, wc, fr2, fq2); }
        if (!has_next) break;
#pragma unroll
        for (int a = 0; a < 2; ++a)
#pragma unroll
            for (int b = 0; b < 2; ++b)
#pragma unroll
                for (int m = 0; m < 4; ++m)
#pragma unroll
                    for (int n = 0; n < 2; ++n) acc[a][b][m][n] = (f32x4){0.f, 0.f, 0.f, 0.f};
        cur = nxt; cA = nA; cB = nB; ++ui;
    }
    PG8_WAIT_V(0);
    if (wr == 0) PG8_BAR;
    PG8_BAR;
#undef PG8_SA
#undef PG8_SB
#undef PG8_STAGE
#undef PG8_LDA
#undef PG8_LDB
#undef PG8_MMA
#undef PG8_WAIT_V
#undef PG8_WAIT_L
#undef PG8_BAR
#undef PG8_SCHED
}

struct EpiGU {
    static constexpr bool PERM = false;
    bf16_t* H;
    __device__ __forceinline__ void operator()(const f32x4 (&acc)[2][2][4][2], const Unit& u, int wr, int wc, int fr, int fq) const {
        const int row0 = u.pm * BM + wr * 64 + fr, col0 = u.pn * 128 + wc * 32 + fq * 8;
#pragma unroll
        for (int ai = 0; ai < 2; ++ai)
#pragma unroll
            for (int m = 0; m < 4; ++m) {
                float h[8];
#pragma unroll
                for (int bj = 0; bj < 2; ++bj)
#pragma unroll
                    for (int j = 0; j < 4; ++j) { const float gt = acc[ai][bj][m][0][j], up = acc[ai][bj][m][1][j]; h[bj * 4 + j] = gt * sigm(gt) * up; }
                u32x4 w; w.x = pk_bf16(h[0], h[1]); w.y = pk_bf16(h[2], h[3]); w.z = pk_bf16(h[4], h[5]); w.w = pk_bf16(h[6], h[7]);
                *(u32x4*)(H + (size_t)(row0 + ai * HALF + m * 16) * 2816 + col0) = w;
            }
    }
};
struct EpiRes {
    static constexpr bool PERM = false;
    const float* res; float* out; float alpha, beta;
    __device__ __forceinline__ void operator()(const f32x4 (&acc)[2][2][4][2], const Unit& u, int wr, int wc, int fr, int fq) const {
        const int row0 = u.pm * BM + wr * 64 + fr, col0 = u.pn * BM + wc * 32 + 4 * fq;
#pragma unroll
        for (int ai = 0; ai < 2; ++ai)
#pragma unroll
            for (int mp = 0; mp < 2; ++mp) {
                f32x4 x[2][2][2];
#pragma unroll
                for (int mm = 0; mm < 2; ++mm)
#pragma unroll
                    for (int bj = 0; bj < 2; ++bj)
#pragma unroll
                        for (int n = 0; n < 2; ++n) x[mm][bj][n] = *(const f32x4*)(res + (size_t)(row0 + ai * HALF + (mp * 2 + mm) * 16) * 1024 + col0 + bj * HALF + n * 16);
#pragma unroll
                for (int mm = 0; mm < 2; ++mm)
#pragma unroll
                    for (int bj = 0; bj < 2; ++bj)
#pragma unroll
                        for (int n = 0; n < 2; ++n) *(f32x4*)(out + (size_t)(row0 + ai * HALF + (mp * 2 + mm) * 16) * 1024 + col0 + bj * HALF + n * 16) = x[mm][bj][n] * alpha + acc[ai][bj][mp * 2 + mm][n] * beta;
            }
    }
};
template <class F> struct EpiP {
    static constexpr bool PERM = true;
    F f;
    __device__ __forceinline__ void operator()(const f32x4 (&acc)[2][2][4][2], const Unit& u, int wr, int wc, int fr, int fq) const {
        const int row0 = u.pm * BM + wr * 64 + fr, cb0 = u.pn * BM + wc * 32 + 8 * fq;
        typename F::Col cv[2];
#pragma unroll
        for (int bj = 0; bj < 2; ++bj) cv[bj] = f.col(cb0 + bj * HALF, u.pn);
#pragma unroll
        for (int ai = 0; ai < 2; ++ai)
#pragma unroll
          for (int mp = 0; mp < 2; ++mp) {
            typename F::Pos pv[2][2];
#pragma unroll
            for (int mm = 0; mm < 2; ++mm)
#pragma unroll
                for (int bj = 0; bj < 2; ++bj) pv[mm][bj] = f.pos(row0 + ai * HALF + (mp * 2 + mm) * 16, cb0 + bj * HALF, u.pn);
#pragma unroll
            for (int mm = 0; mm < 2; ++mm)
#pragma unroll
                for (int bj = 0; bj < 2; ++bj) f.fin(row0 + ai * HALF + (mp * 2 + mm) * 16, cb0 + bj * HALF, acc[ai][bj][mp * 2 + mm][0], acc[ai][bj][mp * 2 + mm][1], u.pn, cv[bj], pv[mm][bj]);
          }
    }
};
struct Col8 { f32x4 a, b; };
struct None {};
__device__ __forceinline__ u32x4 pack8(const f32x4 a, const f32x4 b) { u32x4 w; w.x = pk_bf16(a[0], a[1]); w.y = pk_bf16(a[2], a[3]); w.z = pk_bf16(b[0], b[1]); w.w = pk_bf16(b[2], b[3]); return w; }
__device__ __forceinline__ void unpack8(const u32x4 w, f32x4& a, f32x4& b) { a[0] = bf_lo(w.x); a[1] = bf_hi(w.x); a[2] = bf_lo(w.y); a[3] = bf_hi(w.y); b[0] = bf_lo(w.z); b[1] = bf_hi(w.z); b[2] = bf_lo(w.w); b[3] = bf_hi(w.w); }
__device__ __forceinline__ f32x4 sigm4(const f32x4 x) { f32x4 r; r[0] = sigm(x[0]); r[1] = sigm(x[1]); r[2] = sigm(x[2]); r[3] = sigm(x[3]); return r; }

struct FProj {
    typedef Col8 Col; typedef None Pos;
    bf16_t* QKV; bf16_t* U; const float* bias;
    __device__ __forceinline__ Col col(int cb, int) const { Col c; c.a = *(const f32x4*)(bias + cb); c.b = *(const f32x4*)(bias + cb + 4); return c; }
    __device__ __forceinline__ Pos pos(int, int, int) const { return None{}; }
    __device__ __forceinline__ void fin(int row, int cb, f32x4 v0, f32x4 v1, int pn, const Col& c, const Pos&) const {
        bf16_t* dst = (pn < 3) ? (QKV + (size_t)row * 768 + cb) : (U + (size_t)row * 1792 + (cb - 768));
        *(u32x4*)dst = pack8(v0 + c.a, v1 + c.b);
    }
};
struct FLowRank {
    typedef Col8 Col; typedef None Pos;
    _Float16* EW; bf16_t* A; bf16_t* G; const float* w0; const float* a0;
    __device__ __forceinline__ Col col(int cb, int pn) const { Col c; const float* src = (pn < 2) ? (w0 + cb) : (a0 + ((cb - 512) & 511)); c.a = *(const f32x4*)src; c.b = *(const f32x4*)(src + 4); return c; }
    __device__ __forceinline__ Pos pos(int, int, int) const { return None{}; }
    __device__ __forceinline__ void fin(int row, int cb, f32x4 v0, f32x4 v1, int pn, const Col& c, const Pos&) const {
        if (pn < 2) {
            v0 = sigm4(v0 + c.a) * 0.60653065971f; v1 = sigm4(v1 + c.b) * 0.60653065971f;
            typedef _Float16 h8 __attribute__((ext_vector_type(8)));
            h8 o; o[0] = (_Float16)v0[0]; o[1] = (_Float16)v0[1]; o[2] = (_Float16)v0[2]; o[3] = (_Float16)v0[3]; o[4] = (_Float16)v1[0]; o[5] = (_Float16)v1[1]; o[6] = (_Float16)v1[2]; o[7] = (_Float16)v1[3];
            *(h8*)(EW + (size_t)row * 512 + cb) = o;
        } else if (pn < 4) {
            *(u32x4*)(A + (size_t)row * 512 + (cb - 512)) = pack8(sigm4(v0 + c.a), sigm4(v1 + c.b));
        } else {
            *(u32x4*)(G + (size_t)row * 512 + (cb - 1024)) = pack8(v0, v1);
        }
    }
};
struct FDelta {
    typedef None Col; typedef None Pos;
    bf16_t* D; float beta;
    __device__ __forceinline__ Col col(int, int) const { return None{}; }
    __device__ __forceinline__ Pos pos(int, int, int) const { return None{}; }
    __device__ __forceinline__ void fin(int row, int cb, f32x4 v0, f32x4 v1, int, const Col&, const Pos&) const {
        *(u32x4*)(D + (size_t)row * 1024 + cb) = pack8(v0 * beta, v1 * beta);
    }
};
struct Pos2 { u32x4 a, b; };
struct FVmix {
    typedef Col8 Col; typedef Pos2 Pos;
    const bf16_t* V; const bf16_t* VF; bf16_t* VN; const float* v0p;
    __device__ __forceinline__ Col col(int cb, int) const { Col c; c.a = *(const f32x4*)(v0p + cb); c.b = *(const f32x4*)(v0p + cb + 4); return c; }
    __device__ __forceinline__ Pos pos(int row, int cb, int) const { Pos q; q.a = *(const u32x4*)(V + (size_t)row * 512 + cb); q.b = *(const u32x4*)(VF + (size_t)row * 512 + cb); return q; }
    __device__ __forceinline__ void fin(int row, int cb, f32x4 v0, f32x4 v1, int, const Col& c, const Pos& q) const {
        const f32x4 s0 = sigm4(v0 + c.a), s1 = sigm4(v1 + c.b);
        f32x4 a0, a1, f0, f1; unpack8(q.a, a0, a1); unpack8(q.b, f0, f1);
        *(u32x4*)(VN + (size_t)row * 512 + cb) = pack8(a0 + (f0 - a0) * s0, a1 + (f1 - a1) * s1);
    }
};
struct FGates {
    typedef Col8 Col; typedef None Pos;
    bf16_t* GA; bf16_t* GB; const float* bias;
    __device__ __forceinline__ Col col(int cb, int) const { Col c; c.a = *(const f32x4*)(bias + cb); c.b = *(const f32x4*)(bias + cb + 4); return c; }
    __device__ __forceinline__ Pos pos(int, int, int) const { return None{}; }
    __device__ __forceinline__ void fin(int row, int cb, f32x4 v0, f32x4 v1, int pn, const Col& c, const Pos&) const {
        bf16_t* dst = (pn < 4) ? (GA + (size_t)row * 1024 + cb) : (GB + (size_t)row * 1024 + (cb - 1024));
        *(u32x4*)dst = pack8(sigm4(v0 + c.a), sigm4(v1 + c.b));
    }
};
template <bool ADD> struct FBranch {
    typedef None Col; typedef Pos2 Pos;
    const bf16_t* GT; bf16_t* MB;
    __device__ __forceinline__ Col col(int, int) const { return None{}; }
    __device__ __forceinline__ Pos pos(int row, int cb, int) const { Pos q; q.a = *(const u32x4*)(GT + (size_t)row * 1024 + cb); q.b = ADD ? *(const u32x4*)(MB + (size_t)row * 1024 + cb) : (u32x4){0u, 0u, 0u, 0u}; return q; }
    __device__ __forceinline__ void fin(int row, int cb, f32x4 v0, f32x4 v1, int, const Col&, const Pos& q) const {
        f32x4 g0, g1; unpack8(q.a, g0, g1);
        f32x4 r0 = g0 * v0, r1 = g1 * v1;
        if (ADD) { f32x4 m0, m1; unpack8(q.b, m0, m1); r0 += m0; r1 += m1; }
        *(u32x4*)(MB + (size_t)row * 1024 + cb) = pack8(r0, r1);
    }
};

__device__ __forceinline__ int gu_row(int c) {
    const int nn = c >= 2816 ? 1 : 0, hc = c - 2816 * nn, pn = hc >> 7, rem = hc & 127, wc = rem >> 5, r5 = rem & 31, ih = r5 >> 3, bj = (r5 >> 2) & 1, il = r5 & 3;
    return 256 * pn + bj * 128 + wc * 32 + nn * 16 + ih * 4 + il;
}
__device__ __forceinline__ void wtrans(const float* __restrict__ src, int K, int N, bf16_t* __restrict__ dst, int ldd, int mode, LAS float* tile) {
    const int tid = otid(), tn = N >> 6, nt = (K >> 6) * tn;
    for (int t = obid(); t < nt; t += gridDim.x) {
        const int k0 = (t / tn) << 6, c0 = (t % tn) << 6;
        { const int cl = tid & 63, kl0 = tid >> 6;
#pragma unroll
          for (int i = 0; i < 8; ++i) { const int kl = kl0 + 8 * i; tile[kl * 65 + cl] = src[(size_t)(k0 + kl) * N + c0 + cl]; } }
        __syncthreads();
        { const int kp = tid & 31, cl0 = tid >> 5;
#pragma unroll
          for (int i = 0; i < 4; ++i) { const int cl = cl0 + 16 * i, c = c0 + cl; const int R = mode ? gu_row(c) : c;
              *(unsigned*)(dst + (size_t)R * ldd + k0 + 2 * kp) = pk_bf16(tile[(2 * kp) * 65 + cl], tile[(2 * kp + 1) * 65 + cl]); } }
        __syncthreads();
    }
}
__device__ __forceinline__ void phase_wprep(const Params& p, int l, LAS float* tile) {
    bf16_t* WB = (bf16_t*)(p.ws + WS_WB);
    wtrans(p.in[1] + (size_t)(l * 2 + 0) * 1024 * 5632, 1024, 5632, WB + WB_GU0, 1024, 1, tile);
    wtrans(p.in[1] + (size_t)(l * 2 + 1) * 1024 * 5632, 1024, 5632, WB + WB_GU1, 1024, 1, tile);
    wtrans(p.in[2] + (size_t)(l * 2 + 0) * 2816 * 1024, 2816, 1024, WB + WB_D0, 2816, 0, tile);
    wtrans(p.in[2] + (size_t)(l * 2 + 1) * 2816 * 1024, 2816, 1024, WB + WB_D1, 2816, 0, tile);
    wtrans(p.in[5] + (size_t)l * 1024 * 4608, 1024, 4608, WB + WB_IN, 1024, 0, tile);
    wtrans(p.in[23] + (size_t)l * 512 * 1024, 512, 1024, WB + WB_BA, 512, 0, tile);
    wtrans(p.in[24] + (size_t)l * 512 * 1024, 512, 1024, WB + WB_BB, 512, 0, tile);
    wtrans(p.in[25] + (size_t)l * 1024 * 1024, 1024, 1024, WB + WB_O, 1024, 0, tile);
    const int gt = obid() * 512 + otid(), nth = gridDim.x * 512;
    {
        const float* w2 = p.in[11] + (size_t)l * 64 * 512; const float* a2 = p.in[13] + (size_t)l * 64 * 512; const float* g2 = p.in[14] + (size_t)l * 128 * 512;
        for (int idx = gt; idx < 1536 * 256; idx += nth) { const int n = idx >> 8, k = idx & 255; float v = 0.f;
            if (n < 512) { if (k < 64) v = w2[k * 512 + n]; }
            else if (n < 1024) { if (k >= 64 && k < 128) v = a2[(k - 64) * 512 + (n - 512)]; }
            else { if (k >= 128) v = g2[(k - 128) * 512 + (n - 1024)]; }
            WB[WB_LR + idx] = (bf16_t)(pk_bf16(v, 0.f) & 0xffffu); }
    }
    if (l >= 1) {
        const float* v1 = p.in[21] + (size_t)(l - 1) * 512 * 32; const float* v2 = p.in[22] + (size_t)(l - 1) * 32 * 512;
        for (int idx = gt; idx < 512 * 512; idx += nth) { const int n = idx >> 9, k = idx & 511; float s = 0.f;
#pragma unroll 8
            for (int r = 0; r < 32; ++r) s += v1[k * 32 + r] * v2[r * 512 + n];
            WB[WB_V12 + idx] = (bf16_t)(pk_bf16(s, 0.f) & 0xffffu); }
    }
}
__device__ __forceinline__ void phase_cvt_x(const Params& p) {
    const float* x = p.in[0]; bf16_t* XB = (bf16_t*)(p.ws + WS_XB);
    const size_t n8 = (size_t)M_TOK * 1024 / 8;
    for (size_t i = (size_t)obid() * 512 + otid(); i < n8; i += (size_t)gridDim.x * 512) {
        const f32x4 a = *(const f32x4*)(x + i * 8), b = *(const f32x4*)(x + i * 8 + 4);
        *(u32x4*)(XB + i * 8) = pack8(a, b);
    }
}

__device__ __forceinline__ void phase_ln(const float* RES, const bf16_t* DEL, float* X, bf16_t* XB, const float* g, const float* b, bool write_xb) {
    const int tid = otid(), wid = tid >> 6, lane = tid & 63;
    const int nw = gridDim.x * 8, w0 = obid() * 8 + wid;
    for (int base = w0; base < M_TOK; base += nw * 4) {
        f32x4 v[4][4];
#pragma unroll
        for (int r = 0; r < 4; ++r) { const float* xr = RES + (size_t)(base + r * nw) * 1024; const bf16_t* dr = DEL + (size_t)(base + r * nw) * 1024;
#pragma unroll
            for (int i = 0; i < 2; ++i) { const int c = i * 512 + lane * 8; const f32x4 xa = *(const f32x4*)(xr + c), xb2 = *(const f32x4*)(xr + c + 4); const u32x4 d4 = *(const u32x4*)(dr + c);
                f32x4 da, db; unpack8(d4, da, db); v[r][2 * i] = xa * ALPHA + da; v[r][2 * i + 1] = xb2 * ALPHA + db; } }
        float mean[4], rs[4];
#pragma unroll
        for (int r = 0; r < 4; ++r) { float s = 0.f;
#pragma unroll
            for (int i = 0; i < 4; ++i) s += v[r][i][0] + v[r][i][1] + v[r][i][2] + v[r][i][3];
            mean[r] = wave_sum(s) * (1.f / 1024.f); }
#pragma unroll
        for (int r = 0; r < 4; ++r) { float q = 0.f;
#pragma unroll
            for (int i = 0; i < 4; ++i) { v[r][i] -= mean[r]; q += v[r][i][0] * v[r][i][0] + v[r][i][1] * v[r][i][1] + v[r][i][2] * v[r][i][2] + v[r][i][3] * v[r][i][3]; }
            rs[r] = rsqrtf(wave_sum(q) * (1.f / 1024.f) + 1e-5f); }
#pragma unroll
        for (int i = 0; i < 2; ++i) { const int c = i * 512 + lane * 8;
            const f32x4 ga = *(const f32x4*)(g + c), gb = *(const f32x4*)(g + c + 4), ba = *(const f32x4*)(b + c), bb = *(const f32x4*)(b + c + 4);
#pragma unroll
            for (int r = 0; r < 4; ++r) { const size_t ro = (size_t)(base + r * nw) * 1024 + c;
                const f32x4 oa = v[r][2 * i] * rs[r] * ga + ba, ob = v[r][2 * i + 1] * rs[r] * gb + bb;
                *(f32x4*)(X + ro) = oa; *(f32x4*)(X + ro + 4) = ob;
                if (write_xb) *(u32x4*)(XB + ro) = pack8(oa, ob); } }
    }
}

__device__ __forceinline__ void phase_prep(const Params& p, int l) {
    unsigned char* R = p.ws + WS_R;
    const bf16_t* U = (const bf16_t*)(R + R_U); bf16_t* Rb = (bf16_t*)(R + R_R); bf16_t* Kb = (bf16_t*)(R + R_K); bf16_t* Vb = (bf16_t*)(R + R_V); bf16_t* AP = (bf16_t*)(R + R_AP);
    bf16_t* VF = (bf16_t*)(p.ws + WS_VF);
    const float* mu = p.in[9] + (size_t)l * 1792;
    const int tid = otid(), wid = tid >> 6, lane = tid & 63;
    const bool has3 = lane < 32;
    f32x4 m0[4], m1[4];
#pragma unroll
    for (int i = 0; i < 4; ++i) { const int c = (i < 3 || has3) ? (lane + 64 * i) * 8 : 0; m0[i] = *(const f32x4*)(mu + c); m1[i] = *(const f32x4*)(mu + c + 4); }
    for (int wv = obid() * 8 + wid; wv < M_TOK / 16; wv += gridDim.x * 8) {
        const int row0 = wv * 16;
        u32x4 prv[4], cur[4];
#pragma unroll
        for (int i = 0; i < 4; ++i) { prv[i] = (u32x4){0u, 0u, 0u, 0u}; cur[i] = prv[i]; }
        if ((row0 & (SEQ - 1)) != 0) {
#pragma unroll
            for (int i = 0; i < 4; ++i) if (i < 3 || has3) prv[i] = *(const u32x4*)(U + (size_t)(row0 - 1) * 1792 + (lane + 64 * i) * 8);
        }
#pragma unroll
        for (int i = 0; i < 4; ++i) if (i < 3 || has3) cur[i] = *(const u32x4*)(U + (size_t)row0 * 1792 + (lane + 64 * i) * 8);
#pragma unroll 2
        for (int r = 0; r < 16; ++r) {
            const int row = row0 + r;
            u32x4 nxt[4];
#pragma unroll
            for (int i = 0; i < 4; ++i) { nxt[i] = (u32x4){0u, 0u, 0u, 0u}; if (r < 15 && (i < 3 || has3)) nxt[i] = *(const u32x4*)(U + (size_t)(row + 1) * 1792 + (lane + 64 * i) * 8); }
#pragma unroll
            for (int i = 0; i < 4; ++i) {
                f32x4 c0v, c1v, p0v, p1v; unpack8(cur[i], c0v, c1v); unpack8(prv[i], p0v, p1v);
                f32x4 u0 = c0v + (p0v - c0v) * m0[i], u1 = c1v + (p1v - c1v) * m1[i];
                if (i == 0) *(u32x4*)(Rb + (size_t)row * 512 + lane * 8) = pack8(u0, u1);
                else if (i == 1) *(u32x4*)(Kb + (size_t)row * 512 + lane * 8) = pack8(u0, u1);
                else if (i == 2) { const u32x4 w = pack8(u0, u1); *(u32x4*)(Vb + (size_t)row * 512 + lane * 8) = w; if (l == 0) *(u32x4*)(VF + (size_t)row * 512 + lane * 8) = w; }
                else if (has3) {
                    if (lane < 8) {
#pragma unroll
                        for (int j = 0; j < 4; ++j) { u0[j] = 1.f - 2.f * __builtin_amdgcn_rcpf(__expf(2.f * u0[j]) + 1.f); u1[j] = 1.f - 2.f * __builtin_amdgcn_rcpf(__expf(2.f * u1[j]) + 1.f); }
                    } else if (lane >= 16) { u0 = sigm4(u0); u1 = sigm4(u1); }
                    *(u32x4*)(AP + (size_t)row * 256 + lane * 8) = pack8(u0, u1);
                }
            }
#pragma unroll
            for (int i = 0; i < 4; ++i) { prv[i] = cur[i]; cur[i] = nxt[i]; }
        }
    }
}

__device__ __forceinline__ void lds_barrier() { asm volatile("s_waitcnt lgkmcnt(0)" ::: "memory"); __builtin_amdgcn_s_barrier(); asm volatile("" ::: "memory"); }
constexpr int SC_SLOT = 12288, SC_AT = 0, SC_RT = 2048, SC_BBT = 4096, SC_KBT = 6656, SC_AK = 9216, SC_X = 9728, SC_RB = 10240, SC_RK = 10752, SC_VP = 11264, SC_WC = 11776;
constexpr int SC_BS = 20;
constexpr int SC_NP = 5, SC_RING = 2 * SC_NP * SC_SLOT, SC_SCR = 6144;
__device__ __forceinline__ bf16x8 frag4(LAS const unsigned char* p) { const u32x2 w = *(LAS const u32x2*)p; return __builtin_bit_cast(bf16x8, (u32x4){w.x, w.y, 0u, 0u}); }
__device__ __forceinline__ bf16x8 cfrag(const f32x4 c) { return __builtin_bit_cast(bf16x8, (u32x4){pk_bf16(c[0], c[1]), pk_bf16(c[2], c[3]), 0u, 0u}); }
__device__ __forceinline__ bf16_t bf1(float x) { return (bf16_t)(pk_bf16(x, 0.f) & 0xffffu); }
__device__ __forceinline__ float wave_sum64(float x) { x = row16_sum(x); x += __shfl_xor(x, 16); x += __shfl_xor(x, 32); return x; }
__device__ __forceinline__ void st_mat(LAS unsigned char* rm, LAS unsigned char* tr, LAS unsigned char* trI, LAS unsigned char* rmI, const f32x4 c, int fr, int fq) {
#pragma unroll
    for (int r = 0; r < 4; ++r) { const int t = 4 * fq + r; const float v = c[r], vi = v + (t == fr ? 1.f : 0.f);
        if (rm) *(LAS bf16_t*)(rm + (t * 16 + fr) * 2) = bf1(v);
        if (tr) *(LAS bf16_t*)(tr + (fr * 16 + t) * 2) = bf1(v);
        if (trI) *(LAS bf16_t*)(trI + (fr * 16 + t) * 2) = bf1(vi);
        if (rmI) *(LAS bf16_t*)(rmI + (t * 16 + fr) * 2) = bf1(vi); }
}
__device__ __forceinline__ f32x4 mm16(LAS const unsigned char* Arm, LAS const unsigned char* Btr, int fr, int fq) {
    asm volatile("s_waitcnt lgkmcnt(0)" ::: "memory");
    const bf16x8 a = frag4(Arm + (fr * 16 + 4 * fq) * 2), b = frag4(Btr + (fr * 16 + 4 * fq) * 2);
    return __builtin_amdgcn_mfma_f32_16x16x32_bf16(a, b, (f32x4){0.f, 0.f, 0.f, 0.f}, 0, 0, 0);
}
__device__ __forceinline__ void phase_scan2(const Params& p, int l, LAS unsigned char* lds) {
    unsigned char* R = p.ws + WS_R;
    const bf16_t* Rb = (const bf16_t*)(R + R_R); const bf16_t* Kb = (const bf16_t*)(R + R_K); const bf16_t* Vb = (const bf16_t*)(R + (l == 0 ? R_V : R_VNEW));
    const bf16_t* Ab = (const bf16_t*)(R + R_A); const _Float16* EW = (const _Float16*)(R + R_EW);
    bf16_t* Y = (bf16_t*)(R + R_Y); float* CB = (float*)(R + R_CB);
    const float* k_k = p.in[15] + (size_t)l * 512; const float* k_a = p.in[16] + (size_t)l * 512; const float* r_k = p.in[17] + (size_t)l * 512;
    const int tid = otid(), wid = tid >> 6, lane = tid & 63, fr = lane & 15, fq = lane >> 4;
    constexpr int NCH = SEQ / 16, NRD = (NCH + SC_NP - 1) / SC_NP;
    for (int job = obid(); job < 256; job += gridDim.x) {
        const int bh = job >> 2, rg = job & 3, b = bh >> 3, h = bh & 7;
        const size_t tok0 = (size_t)b * SEQ;
        const int pw = wid - 3, j = lane;
        const float kkc = k_k[h * 64 + j], kac = k_a[h * 64 + j], rkc = r_k[h * 64 + j];
        unsigned short kraw[16], araw[16], rraw[16]; _Float16 eraw[16]; unsigned short vraw[4];
#pragma unroll
        for (int t = 0; t < 16; ++t) { kraw[t] = 0; araw[t] = 0; rraw[t] = 0; eraw[t] = (_Float16)0; }
#pragma unroll
        for (int q = 0; q < 4; ++q) vraw[q] = 0;
        auto pload = [&](int c) {
            const size_t base = (tok0 + (size_t)c * 16) * 512 + h * 64;
#pragma unroll
            for (int t = 0; t < 16; ++t) { const size_t off = base + (size_t)t * 512 + j; kraw[t] = Kb[off]; araw[t] = Ab[off]; rraw[t] = Rb[off]; eraw[t] = EW[off]; }
#pragma unroll
            for (int q = 0; q < 4; ++q) vraw[q] = Vb[base + (size_t)(4 * fq + q) * 512 + rg * 16 + fr];
        };
        auto pbuild = [&](int c, LAS unsigned char* sl, LAS unsigned char* sc, int cnext) {
            float W = 1.f;
            const int m = j >> 5, tp = (j >> 4) & 1, jw = j & 15, pidx = (jw >> 2) * 8 + tp * 4 + (jw & 3);
#pragma unroll
            for (int t = 0; t < 16; ++t) {
                const float k = bf2f(kraw[t]), a = bf2f(araw[t]), r = bf2f(rraw[t]);
                const float q = k * kkc, kp1 = k * (1.f + (a - 1.f) * kac);
                *(LAS bf16_t*)(sc + 0 + (t * 64 + j) * 2) = bf1(q * q);
                *(LAS bf16_t*)(sc + 2048 + (t * 64 + j) * 2) = bf1(r * kp1 * rkc);
            }
            asm volatile("s_waitcnt lgkmcnt(0)" ::: "memory");
            { const bf16x8 ones = __builtin_bit_cast(bf16x8, (u32x4){0x3F803F80u, 0x3F803F80u, 0x3F803F80u, 0x3F803F80u});
              f32x4 sq = (f32x4){0.f, 0.f, 0.f, 0.f}, sb = sq;
#pragma unroll
              for (int kk2 = 0; kk2 < 2; ++kk2) {
                  const bf16x8 fa = *(LAS const bf16x8*)(sc + 0 + (fr * 64 + kk2 * 32 + fq * 8) * 2), fu = *(LAS const bf16x8*)(sc + 2048 + (fr * 64 + kk2 * 32 + fq * 8) * 2);
                  sq = __builtin_amdgcn_mfma_f32_16x16x32_bf16(fa, ones, sq, 0, 0, 0); sb = __builtin_amdgcn_mfma_f32_16x16x32_bf16(fu, ones, sb, 0, 0, 0);
              }
              if (fr == 0) { *(LAS f32x4*)(sl + SC_X + fq * 16) = sq; *(LAS f32x4*)(sl + SC_X + 64 + fq * 16) = sb; }
              asm volatile("s_waitcnt lgkmcnt(0)" ::: "memory");
              if (rg == 0 && lane < 16) CB[(tok0 + (size_t)c * 16 + lane) * 8 + h] = *(LAS const float*)(sl + SC_X + 64 + lane * 4);
              asm volatile("s_waitcnt lgkmcnt(0)" ::: "memory");
            }
#pragma unroll
            for (int t = 0; t < 16; ++t) {
                const float k = bf2f(kraw[t]), a = bf2f(araw[t]), r = bf2f(rraw[t]), ew = (float)eraw[t];
                const float kk = k * kkc * rsqrtf(fmaxf(*(LAS const float*)(sl + SC_X + t * 4), 1e-24f));
                const float kp = k * (1.f + (a - 1.f) * kac);
                const float at = -kk * W;
                W *= __expf(-ew);
                const float rt = r * W, iw = __builtin_amdgcn_rcpf(W);
                const unsigned wbk = pk_bf16(kk * a * iw, kp * iw), war = pk_bf16(at, rt);
                const bf16_t bh = (bf16_t)(wbk & 0xffffu), kh = (bf16_t)(wbk >> 16), ah = (bf16_t)(war & 0xffffu), rh = (bf16_t)(war >> 16);
                *(LAS bf16_t*)(sl + SC_AT + ((m * 16 + t) * 32 + pidx) * 2) = ah;
                *(LAS bf16_t*)(sl + SC_RT + ((m * 16 + t) * 32 + pidx) * 2) = rh;
                *(LAS bf16_t*)(sl + SC_BBT + (j * SC_BS + t) * 2) = bh;
                *(LAS bf16_t*)(sl + SC_KBT + (j * SC_BS + t) * 2) = kh;
                *(LAS bf16_t*)(sc + 0 + ((m * 16 + t) * 32 + pidx) * 2) = bh;
                *(LAS bf16_t*)(sc + 2048 + ((m * 16 + t) * 32 + pidx) * 2) = kh;
            }
            *(LAS float*)(sl + SC_WC + j * 4) = W;
#pragma unroll
            for (int q = 0; q < 4; ++q) *(LAS bf16_t*)(sl + SC_VP + (fr * 16 + 4 * fq + q) * 2) = vraw[q];
            if (cnext >= 0) pload(cnext);
            asm volatile("s_waitcnt lgkmcnt(0)" ::: "memory");
            f32x4 AB = (f32x4){0.f, 0.f, 0.f, 0.f}, AKm = AB, RBm = AB, RKm = AB;
#pragma unroll
            for (int kk2 = 0; kk2 < 2; ++kk2) {
                const int fo = ((kk2 * 16 + fr) * 32 + fq * 8) * 2;
                const bf16x8 fa = *(LAS const bf16x8*)(sl + SC_AT + fo), fr_ = *(LAS const bf16x8*)(sl + SC_RT + fo);
                const bf16x8 fb = *(LAS const bf16x8*)(sc + 0 + fo), fk = *(LAS const bf16x8*)(sc + 2048 + fo);
                AB = __builtin_amdgcn_mfma_f32_16x16x32_bf16(fa, fb, AB, 0, 0, 0); AKm = __builtin_amdgcn_mfma_f32_16x16x32_bf16(fa, fk, AKm, 0, 0, 0);
                RBm = __builtin_amdgcn_mfma_f32_16x16x32_bf16(fr_, fb, RBm, 0, 0, 0); RKm = __builtin_amdgcn_mfma_f32_16x16x32_bf16(fr_, fk, RKm, 0, 0, 0);
            }
#pragma unroll
            for (int r = 0; r < 4; ++r) { const int t = 4 * fq + r; const bool lo = fr < t, le = fr <= t;
                AB[r] = lo ? AB[r] : 0.f; AKm[r] = lo ? AKm[r] : 0.f; RBm[r] = le ? RBm[r] : 0.f; RKm[r] = le ? RKm[r] : 0.f; }
            asm volatile("s_waitcnt lgkmcnt(0)" ::: "memory");
            st_mat(sl + SC_AK, nullptr, nullptr, nullptr, AKm, fr, fq);
            st_mat(sl + SC_RB, nullptr, nullptr, nullptr, RBm, fr, fq);
            st_mat(sl + SC_RK, nullptr, nullptr, nullptr, RKm, fr, fq);
            LAS unsigned char* mL = sc, *mLT = sc + 512, *mIL = sc + 1024, *mL2 = sc + 1536, *mL2T = sc + 2048, *mIL2T = sc + 2560, *mL4 = sc + 3072, *mL4T = sc + 3584, *mIL4T = sc + 4096, *mIL8T = sc + 4608, *mP1 = sc + 5120, *mP2 = sc + 5632;
            st_mat(mL, mLT, nullptr, mIL, AB, fr, fq);
            const f32x4 L2 = mm16(mL, mLT, fr, fq);      st_mat(mL2, mL2T, mIL2T, nullptr, L2, fr, fq);
            const f32x4 L4 = mm16(mL2, mL2T, fr, fq);    const f32x4 P1 = mm16(mIL, mIL2T, fr, fq);
            st_mat(mL4, mL4T, mIL4T, nullptr, L4, fr, fq); st_mat(mP1, nullptr, nullptr, nullptr, P1, fr, fq);
            const f32x4 L8 = mm16(mL4, mL4T, fr, fq);    const f32x4 P2 = mm16(mP1, mIL4T, fr, fq);
            st_mat(nullptr, nullptr, mIL8T, nullptr, L8, fr, fq); st_mat(mP2, nullptr, nullptr, nullptr, P2, fr, fq);
            const f32x4 X = mm16(mP2, mIL8T, fr, fq);    st_mat(sl + SC_X, nullptr, nullptr, nullptr, X, fr, fq);
            asm volatile("s_waitcnt lgkmcnt(0)" ::: "memory");
        };
        f32x4 ST[4];
#pragma unroll
        for (int jt = 0; jt < 4; ++jt) ST[jt] = (f32x4){0.f, 0.f, 0.f, 0.f};
        auto consume = [&](int c, LAS const unsigned char* sl) {
            const bf16x8 s0 = __builtin_bit_cast(bf16x8, (u32x4){pk_bf16(ST[0][0], ST[0][1]), pk_bf16(ST[0][2], ST[0][3]), pk_bf16(ST[1][0], ST[1][1]), pk_bf16(ST[1][2], ST[1][3])});
            const bf16x8 s1 = __builtin_bit_cast(bf16x8, (u32x4){pk_bf16(ST[2][0], ST[2][1]), pk_bf16(ST[2][2], ST[2][3]), pk_bf16(ST[3][0], ST[3][1]), pk_bf16(ST[3][2], ST[3][3])});
            const bf16x8 at0 = *(LAS const bf16x8*)(sl + SC_AT + (fr * 32 + fq * 8) * 2), at1 = *(LAS const bf16x8*)(sl + SC_AT + ((16 + fr) * 32 + fq * 8) * 2);
            const bf16x8 rt0 = *(LAS const bf16x8*)(sl + SC_RT + (fr * 32 + fq * 8) * 2), rt1 = *(LAS const bf16x8*)(sl + SC_RT + ((16 + fr) * 32 + fq * 8) * 2);
            const int mo = (fr * 16 + 4 * fq) * 2;
            const bf16x8 vf = frag4(sl + SC_VP + mo), akf = frag4(sl + SC_AK + mo), xf = frag4(sl + SC_X + mo), rbf = frag4(sl + SC_RB + mo), rkf = frag4(sl + SC_RK + mo);
            const f32x4 z = (f32x4){0.f, 0.f, 0.f, 0.f};
            f32x4 g = __builtin_amdgcn_mfma_f32_16x16x32_bf16(at0, s0, z, 0, 0, 0);
            g = __builtin_amdgcn_mfma_f32_16x16x32_bf16(at1, s1, g, 0, 0, 0);
            g = __builtin_amdgcn_mfma_f32_16x16x32_bf16(akf, vf, g, 0, 0, 0);
            const f32x4 sa = __builtin_amdgcn_mfma_f32_16x16x32_bf16(xf, cfrag(g), z, 0, 0, 0);
            const bf16x8 saf = cfrag(sa);
            f32x4 y = __builtin_amdgcn_mfma_f32_16x16x32_bf16(rt0, s0, z, 0, 0, 0);
            y = __builtin_amdgcn_mfma_f32_16x16x32_bf16(rt1, s1, y, 0, 0, 0);
            y = __builtin_amdgcn_mfma_f32_16x16x32_bf16(rbf, saf, y, 0, 0, 0);
            y = __builtin_amdgcn_mfma_f32_16x16x32_bf16(rkf, vf, y, 0, 0, 0);
#pragma unroll
            for (int jt = 0; jt < 4; ++jt) {
                const f32x4 wc = *(LAS const f32x4*)(sl + SC_WC + (16 * jt + 4 * fq) * 4);
                const bf16x8 bb = frag4(sl + SC_BBT + ((16 * jt + fr) * SC_BS + 4 * fq) * 2), kb = frag4(sl + SC_KBT + ((16 * jt + fr) * SC_BS + 4 * fq) * 2);
                f32x4 acc = ST[jt];
                acc = __builtin_amdgcn_mfma_f32_16x16x32_bf16(bb, saf, acc, 0, 0, 0);
                acc = __builtin_amdgcn_mfma_f32_16x16x32_bf16(kb, vf, acc, 0, 0, 0);
                ST[jt] = acc * wc;
            }
#pragma unroll
            for (int r = 0; r < 4; ++r) Y[(tok0 + (size_t)c * 16 + 4 * fq + r) * 512 + h * 64 + rg * 16 + fr] = bf1(y[r]);
        };
        LAS unsigned char* scr = lds + SC_RING + (pw < 0 ? 0 : pw) * SC_SCR;
        if (wid >= 3) { pload(pw); pbuild(pw, lds + pw * SC_SLOT, scr, SC_NP + pw); }
        lds_barrier();
        for (int rd = 0; rd < NRD; ++rd) {
            if (wid == 0) {
#pragma unroll 1
                for (int q = 0; q < SC_NP; ++q) { const int c = rd * SC_NP + q; if (c < NCH) consume(c, lds + ((rd & 1) * SC_NP + q) * SC_SLOT); }
            } else if (wid >= 3) {
                const int cb = (rd + 1) * SC_NP + pw, cn = cb + SC_NP;
                if (cb < NCH) pbuild(cb, lds + (((rd + 1) & 1) * SC_NP + pw) * SC_SLOT, scr, cn < NCH ? cn : -1);
            }
            lds_barrier();
        }
        __syncthreads();
    }
}

__device__ __forceinline__ void phase_attn(const Params& p, int l, LAS unsigned char* ldsb) {
    unsigned char* R = p.ws + WS_R;
    const bf16_t* QKV = (const bf16_t*)(R + R_QKV); bf16_t* ATT = (bf16_t*)(R + R_ATT);
    const float* relb = p.in[7]; const float* sinks = p.in[8] + l * 8;
    const int tid = otid(), wid = tid >> 6, lane = tid & 63, fr = lane & 15, fq = lane >> 4;
    LAS bf16_t* Ks = (LAS bf16_t*)ldsb;
    LAS bf16_t* Vt = (LAS bf16_t*)(ldsb + 36864);
    LAS float* biasL = (LAS float*)(ldsb + 70656);
    LAS bf16_t* Pw = (LAS bf16_t*)(ldsb + 72704) + wid * (16 * 168);
    for (int item = obid(); item < 512; item += gridDim.x) {
        const int g = item & 1, n = (item >> 1) & 31, b = item >> 6;
        const long tokc = (long)b * SEQ + n * 128, tokp = tokc - 128;
        for (int idx = tid; idx < 2048; idx += 512) {
            const int key = idx >> 3, d8 = idx & 7; u32x4 v = (u32x4){0u, 0u, 0u, 0u}, kv = (u32x4){0u, 0u, 0u, 0u};
            if (n > 0 || key >= 128) { const bf16_t* src = QKV + (size_t)(tokp + key) * 768 + 512 + g * 64 + d8 * 8; kv = *(const u32x4*)src; v = *(const u32x4*)(src + 128); }
            *(LAS u32x4*)(Ks + key * 72 + d8 * 8) = kv;
#pragma unroll
            for (int e = 0; e < 8; ++e) Vt[(d8 * 8 + e) * 264 + key] = (bf16_t)((e & 1) ? (v[e >> 1] >> 16) : (v[e >> 1] & 0xffffu));
        }
        { const int hl = tid >> 7, d = tid & 127; int bk = d;
          if (d >= 16) { bk = 16 + (int)(__logf((float)d * 0.0625f) * (16.f / 2.07944154168f)); bk = bk > 31 ? 31 : bk; }
          biasL[tid] = relb[bk * 8 + g * 4 + hl]; }
        __syncthreads();
        const int hl = wid >> 1, hq = g * 4 + hl; const float sink = sinks[hq];
        for (int rt = 0; rt < 4; ++rt) {
            const int q0 = (wid & 1) * 64 + rt * 16, kstart = q0 < 96 ? q0 : 96;
            bf16x8 qa0, qa1; { const bf16_t* qp = QKV + (size_t)(tokc + q0 + fr) * 768 + hq * 64 + fq * 8; qa0 = *(const bf16x8*)qp; qa1 = *(const bf16x8*)(qp + 32); }
            f32x4 S[10];
#pragma unroll
            for (int kt = 0; kt < 10; ++kt) {
                LAS const bf16_t* kp = Ks + (kstart + kt * 16 + fr) * 72 + fq * 8;
                const bf16x8 k0 = *(LAS const bf16x8*)kp, k1 = *(LAS const bf16x8*)(kp + 32);
                f32x4 z = (f32x4){0.f, 0.f, 0.f, 0.f};
                z = __builtin_amdgcn_mfma_f32_16x16x32_bf16(qa0, k0, z, 0, 0, 0);
                z = __builtin_amdgcn_mfma_f32_16x16x32_bf16(qa1, k1, z, 0, 0, 0);
                S[kt] = z;
            }
            float mx[4] = {-INFINITY, -INFINITY, -INFINITY, -INFINITY};
#pragma unroll
            for (int kt = 0; kt < 10; ++kt)
#pragma unroll
                for (int j = 0; j < 4; ++j) {
                    const int key = kstart + kt * 16 + fr, dist = q0 + 4 * fq + j + 128 - key;
                    const bool ok = (dist >= 0) && (dist < 128) && (n > 0 || key >= 128);
                    const float s = ok ? (S[kt][j] * 0.125f + biasL[hl * 128 + (dist & 127)]) : -INFINITY;
                    S[kt][j] = s; mx[j] = fmaxf(mx[j], s);
                }
            float inv[4];
#pragma unroll
            for (int j = 0; j < 4; ++j) mx[j] = fmaxf(row16_max(mx[j]), sink);
            float sm[4] = {0.f, 0.f, 0.f, 0.f};
#pragma unroll
            for (int kt = 0; kt < 10; ++kt)
#pragma unroll
                for (int j = 0; j < 4; ++j) { const float e = __expf(S[kt][j] - mx[j]); S[kt][j] = e; sm[j] += e; }
#pragma unroll
            for (int j = 0; j < 4; ++j) inv[j] = 1.f / (row16_sum(sm[j]) + __expf(sink - mx[j]));
#pragma unroll
            for (int kt = 0; kt < 10; ++kt)
#pragma unroll
                for (int j = 0; j < 4; ++j) Pw[(4 * fq + j) * 168 + kt * 16 + fr] = (bf16_t)(pk_bf16(S[kt][j] * inv[j], 0.f) & 0xffffu);
            asm volatile("s_waitcnt lgkmcnt(0)" ::: "memory");
            __builtin_amdgcn_wave_barrier();
            f32x4 O[4];
#pragma unroll
            for (int dt = 0; dt < 4; ++dt) O[dt] = (f32x4){0.f, 0.f, 0.f, 0.f};
#pragma unroll
            for (int kk = 0; kk < 5; ++kk) {
                const bf16x8 pa = *(LAS const bf16x8*)(Pw + fr * 168 + kk * 32 + fq * 8);
#pragma unroll
                for (int dt = 0; dt < 4; ++dt) {
                    const bf16x8 vb = *(LAS const bf16x8*)(Vt + (dt * 16 + fr) * 264 + kstart + kk * 32 + fq * 8);
                    O[dt] = __builtin_amdgcn_mfma_f32_16x16x32_bf16(pa, vb, O[dt], 0, 0, 0);
                }
            }
#pragma unroll
            for (int dt = 0; dt < 4; ++dt)
#pragma unroll
                for (int j = 0; j < 4; ++j) ATT[(size_t)(tokc + q0 + 4 * fq + j) * 512 + hq * 64 + dt * 16 + fr] = (bf16_t)(pk_bf16(O[dt][j], 0.f) & 0xffffu);
            asm volatile("s_waitcnt lgkmcnt(0)" ::: "memory");
            __builtin_amdgcn_wave_barrier();
        }
        __syncthreads();
    }
}

__device__ __forceinline__ void phase_post(const Params& p, int l) {
    unsigned char* R = p.ws + WS_R;
    bf16_t* Y = (bf16_t*)(R + R_Y); const bf16_t* Vb = (const bf16_t*)(R + (l == 0 ? R_V : R_VNEW)); const bf16_t* G = (const bf16_t*)(R + R_G); const float* CB = (const float*)(R + R_CB);
    const float* gng = p.in[18] + (size_t)l * 512; const float* gnb = p.in[19] + (size_t)l * 512;
    const size_t total = (size_t)M_TOK * 64;
    for (size_t it = (size_t)obid() * 512 + otid(); it < total; it += (size_t)gridDim.x * 512) {
        const size_t row = it >> 6; const int c0 = (int)(it & 63) * 8, h = c0 >> 6;
        f32x4 y0, y1; unpack8(*(const u32x4*)(Y + row * 512 + c0), y0, y1);
        float s = y0[0] + y0[1] + y0[2] + y0[3] + y1[0] + y1[1] + y1[2] + y1[3];
        s += dpp_f<0xB1>(s); s += dpp_f<0x4E>(s); s += dpp_f<0x141>(s);
        const float mu = s * (1.f / 64.f);
        y0 -= mu; y1 -= mu;
        float q = y0[0] * y0[0] + y0[1] * y0[1] + y0[2] * y0[2] + y0[3] * y0[3] + y1[0] * y1[0] + y1[1] * y1[1] + y1[2] * y1[2] + y1[3] * y1[3];
        q += dpp_f<0xB1>(q); q += dpp_f<0x4E>(q); q += dpp_f<0x141>(q);
        const float rs = rsqrtf(q * (1.f / 64.f) + 64e-5f);
        f32x4 v0, v1, g0, g1; unpack8(*(const u32x4*)(Vb + row * 512 + c0), v0, v1); unpack8(*(const u32x4*)(G + row * 512 + c0), g0, g1);
        const float cb = CB[row * 8 + h];
        const f32x4 gg0 = *(const f32x4*)(gng + c0), gg1 = *(const f32x4*)(gng + c0 + 4), gb0 = *(const f32x4*)(gnb + c0), gb1 = *(const f32x4*)(gnb + c0 + 4);
        const f32x4 o0 = (y0 * rs * gg0 + gb0 + v0 * cb) * g0, o1 = (y1 * rs * gg1 + gb1 + v1 * cb) * g1;
        *(u32x4*)(Y + row * 512 + c0) = pack8(o0, o1);
    }
}


#define XB_TMO      128
#define XB_XCNT(j)  (256  + 64 * (j))
#define XB_XSUB(j)  (1280 + 64 * (j))
#define XB_XGEN(j)  (2304 + 64 * (j))
#define XB_TOP      3328
#define XB_TOPGEN   3392
#define XCD_BAR_WORDS 3456
#define XB_SPIN_CAP (1u << 20)
__device__ __forceinline__ unsigned xb_ld(unsigned* p)              { return __hip_atomic_load(p, __ATOMIC_RELAXED, __HIP_MEMORY_SCOPE_AGENT); }
__device__ __forceinline__ unsigned xb_add(unsigned* p, unsigned v) { return __hip_atomic_fetch_add(p, v, __ATOMIC_RELAXED, __HIP_MEMORY_SCOPE_AGENT); }
__device__ __forceinline__ unsigned xb_xcc_id() { return (unsigned)__builtin_amdgcn_s_getreg((3 << 11) | 20) & 0xFu; }
#define XB_SPIN(cond, bar) do { unsigned _sp = 0; while (cond) { __builtin_amdgcn_s_sleep(1); \
    if ((++_sp & 255u) == 0u) { if (xb_ld(&(bar)[XB_TMO])) break; if (_sp > XB_SPIN_CAP) { atomicAdd(&(bar)[XB_TMO], 1u); break; } } } } while (0)
struct XcdBarrier { unsigned* bar; unsigned x; volatile LAS unsigned* st; };
__device__ __forceinline__ XcdBarrier xcd_barrier_post(unsigned* bar, volatile LAS unsigned* st) {
    XcdBarrier b; b.bar = bar; b.x = xb_xcc_id(); b.st = st;
    if (threadIdx.x == 0) (void)xb_add(&bar[XB_XCNT(b.x)], 1u);
    return b;
}
__device__ __forceinline__ void xcd_barrier_complete(unsigned* bar, unsigned x, unsigned& nloc, unsigned& nx) {
    const unsigned G = gridDim.x * gridDim.y * gridDim.z;
    unsigned sum, cnt, mine, sp = 0u;
    for (;;) {
        sum = 0u; cnt = 0u; mine = 0u;
#pragma unroll
        for (unsigned j = 0; j < 16; ++j) { const unsigned c = xb_ld(&bar[XB_XCNT(j)]); sum += c; cnt += (c > 0u) ? 1u : 0u; mine = (j == x) ? c : mine; }
        if (sum == G) break;
        __builtin_amdgcn_s_sleep(1);
        if ((++sp & 255u) == 0u) { if (xb_ld(&bar[XB_TMO])) break; if (sp > XB_SPIN_CAP) { atomicAdd(&bar[XB_TMO], 1u); break; } }
    }
    nloc = mine > 0u ? mine : 1u; nx = cnt > 0u ? cnt : 1u;
}
__device__ __forceinline__ void xcd_barrier(const XcdBarrier& b) {
    asm volatile("s_waitcnt vmcnt(0)" ::: "memory");
    __syncthreads();
    if (threadIdx.x == 0) {
        unsigned* bar = b.bar;
        __builtin_amdgcn_s_waitcnt(0);
        unsigned nloc = b.st[0], nx = b.st[1];
        if (nloc == 0u) { xcd_barrier_complete(bar, b.x, nloc, nx); b.st[0] = nloc; b.st[1] = nx; }
        const unsigned old = xb_add(&bar[XB_XSUB(b.x)], 1u);
        const unsigned gen = old / nloc;
        if (old + 1u == (gen + 1u) * nloc) {
            __builtin_amdgcn_fence(__ATOMIC_RELEASE, "agent");
            asm volatile("s_waitcnt vmcnt(0)" ::: "memory");
            const unsigned og = xb_add(&bar[XB_TOP], 1u);
            const unsigned tg = og / nx;
            if (og + 1u == (tg + 1u) * nx) xb_add(&bar[XB_TOPGEN], 1u);
            else XB_SPIN(xb_ld(&bar[XB_TOPGEN]) == tg, bar);
            __builtin_amdgcn_fence(__ATOMIC_ACQUIRE, "agent");
            xb_add(&bar[XB_XGEN(b.x)], 1u);
            asm volatile("s_waitcnt vmcnt(0)" ::: "memory");
        } else {
            XB_SPIN(xb_ld(&bar[XB_XGEN(b.x)]) == gen, bar);
            __builtin_amdgcn_fence(__ATOMIC_ACQUIRE, "agent");
            asm volatile("s_waitcnt vmcnt(0)" ::: "memory");
        }
    }
    __syncthreads();
}

__device__ __forceinline__ void gsync(cg::grid_group& grid) {
    asm volatile("s_waitcnt vmcnt(0) lgkmcnt(0)" ::: "memory");
    grid.sync();
    __builtin_amdgcn_fence(__ATOMIC_ACQUIRE, "agent");
    asm volatile("s_waitcnt vmcnt(0)" ::: "memory");
}
__global__ void __launch_bounds__(512, 2) fwd_kernel(Params p) {
    extern __shared__ __attribute__((aligned(16))) unsigned char shm[];
    LAS unsigned char* lds = (LAS unsigned char*)shm;
    cg::grid_group grid = cg::this_grid();
    unsigned char* R = p.ws + WS_R;
    const bf16_t* WB = (const bf16_t*)(p.ws + WS_WB);
    bf16_t* XB = (bf16_t*)(p.ws + WS_XB);

    volatile LAS unsigned* xst = (volatile LAS unsigned*)(lds + LDS_XB);
    if (threadIdx.x == 0) { xst[0] = 0u; xst[1] = 0u; }
    __syncthreads();
    const XcdBarrier xb = xcd_barrier_post((unsigned*)(p.ws + WS_BAR), xst);
    phase_cvt_x(p);
    phase_wprep(p, 0, (LAS float*)lds);
    gsync(grid);
#pragma unroll 1
    for (int hs = 0; hs < 4; ++hs) {
        const int l = hs >> 1, j = hs & 1;
        { Gemm g; g.A = XB; g.Bt = WB + (j ? WB_GU1 : WB_GU0); g.M = M_TOK; g.N = 5632; g.K = 1024;
          EpiGU e; e.H = (bf16_t*)(R + R_HB); gemm_phase(lds, g, e); }
        xcd_barrier(xb);
        { Gemm g; g.A = (const bf16_t*)(R + R_HB); g.Bt = WB + (j ? WB_D1 : WB_D0); g.M = M_TOK; g.N = 1024; g.K = 2816;
          EpiP<FDelta> e; e.f.D = (bf16_t*)(R + R_DEL); e.f.beta = 0.5f; gemm_phase(lds, g, e); }
        xcd_barrier(xb);
        { const int li = l * 3 + (j ? 2 : 0); phase_ln((hs == 0) ? p.in[0] : p.out, (const bf16_t*)(R + R_DEL), p.out, XB, p.in[3] + (size_t)li * 1024, p.in[4] + (size_t)li * 1024, hs != 3); }
        if (hs == 1) phase_wprep(p, 1, (LAS float*)lds);
        xcd_barrier(xb);
        if (j == 0) {
            { Gemm g; g.A = XB; g.Bt = WB + WB_IN + (size_t)2048 * 1024; g.M = M_TOK; g.N = 2560; g.K = 1024;
              EpiP<FProj> e; e.f.QKV = (bf16_t*)(R + R_QKV); e.f.U = (bf16_t*)(R + R_U); e.f.bias = p.in[6] + (size_t)l * 4608 + 2048; gemm_phase(lds, g, e); }
            xcd_barrier(xb);
            phase_prep(p, l);
            xcd_barrier(xb);
            { Gemm g; g.A = (const bf16_t*)(R + R_AP); g.Bt = WB + WB_LR; g.M = M_TOK; g.N = 1536; g.K = 256;
              EpiP<FLowRank> e; e.f.EW = (_Float16*)(R + R_EW); e.f.A = (bf16_t*)(R + R_A); e.f.G = (bf16_t*)(R + R_G); e.f.w0 = p.in[10] + (size_t)l * 512; e.f.a0 = p.in[12] + (size_t)l * 512;
              gemm_phase(lds, g, e); }
            if (l >= 1) {
                Gemm g; g.A = (const bf16_t*)(R + R_V); g.Bt = WB + WB_V12; g.M = M_TOK; g.N = 512; g.K = 512;
                EpiP<FVmix> e; e.f.V = (const bf16_t*)(R + R_V); e.f.VF = (const bf16_t*)(p.ws + WS_VF); e.f.VN = (bf16_t*)(R + R_VNEW); e.f.v0p = p.in[20] + (size_t)(l - 1) * 512;
                gemm_phase(lds, g, e);
            }
            xcd_barrier(xb);
            phase_scan2(p, l, lds);
            phase_attn(p, l, lds);
            xcd_barrier(xb);
            phase_post(p, l);
            { Gemm g; g.A = XB; g.Bt = WB + WB_IN; g.M = M_TOK; g.N = 2048; g.K = 1024;
              EpiP<FGates> e; e.f.GA = (bf16_t*)(R + R_GA); e.f.GB = (bf16_t*)(R + R_GB); e.f.bias = p.in[6] + (size_t)l * 4608; gemm_phase(lds, g, e); }
            xcd_barrier(xb);
            { Gemm g; g.A = (const bf16_t*)(R + R_ATT); g.Bt = WB + WB_BA; g.M = M_TOK; g.N = 1024; g.K = 512;
              EpiP<FBranch<false>> e; e.f.GT = (const bf16_t*)(R + R_GA); e.f.MB = (bf16_t*)(R + R_MB); gemm_phase(lds, g, e); }
            asm volatile("s_waitcnt vmcnt(0)" ::: "memory");
            { Gemm g; g.A = (const bf16_t*)(R + R_Y); g.Bt = WB + WB_BB; g.M = M_TOK; g.N = 1024; g.K = 512;
              EpiP<FBranch<true>> e; e.f.GT = (const bf16_t*)(R + R_GB); e.f.MB = (bf16_t*)(R + R_MB); gemm_phase(lds, g, e); }
            xcd_barrier(xb);
            { Gemm g; g.A = (const bf16_t*)(R + R_MB); g.Bt = WB + WB_O; g.M = M_TOK; g.N = 1024; g.K = 1024;
              EpiP<FDelta> e; e.f.D = (bf16_t*)(R + R_DEL); e.f.beta = 1.0f; gemm_phase(lds, g, e); }
            xcd_barrier(xb);
            { const int li = l * 3 + 1; phase_ln(p.out, (const bf16_t*)(R + R_DEL), p.out, XB, p.in[3] + (size_t)li * 1024, p.in[4] + (size_t)li * 1024, true); }
            xcd_barrier(xb);
        }
    }
}

extern "C" void kernel_launch(void* const* d_in, const int* in_sizes, int n_in, void* d_out, int out_size, void* d_ws, size_t ws_size, hipStream_t stream) {
    static int grid = 0;
    if (grid == 0) {
        if (n_in != 26 || ws_size < WS_END) { grid = -1; return; }
        int dev = 0, cus = 0, per_cu = 0;
        (void)hipGetDevice(&dev);
        (void)hipDeviceGetAttribute(&cus, hipDeviceAttributeMultiprocessorCount, dev);
        (void)hipFuncSetAttribute((const void*)fwd_kernel, hipFuncAttributeMaxDynamicSharedMemorySize, LDS_BYTES);
        if (hipOccupancyMaxActiveBlocksPerMultiprocessor(&per_cu, (const void*)fwd_kernel, 512, LDS_BYTES) != hipSuccess || per_cu < 1) per_cu = 1;
        (void)hipGetLastError();
        grid = cus * 1;
        if (grid <= 0) grid = 256;
    }
    if (grid < 0) return;
    (void)hipMemsetAsync((unsigned char*)d_ws + WS_BAR, 0, XCD_BAR_WORDS * sizeof(unsigned), stream);
    Params p{};
    for (int i = 0; i < 26; ++i) p.in[i] = (const float*)d_in[i];
    p.out = (float*)d_out; p.ws = (unsigned char*)d_ws;
    void* args[] = {&p};
    (void)hipLaunchCooperativeKernel((const void*)fwd_kernel, dim3(grid), dim3(512), args, LDS_BYTES, stream);
}
```

```cpp
#include <hip/hip_runtime.h>
#include <hip/hip_cooperative_groups.h>
#include <math.h>
namespace cg = cooperative_groups;

#define LAS __attribute__((address_space(3)))
typedef unsigned short bf16_t;
typedef short bf16x8 __attribute__((ext_vector_type(8)));
typedef float f32x4 __attribute__((ext_vector_type(4)));
typedef unsigned u32x4 __attribute__((ext_vector_type(4)));
typedef unsigned u32x2 __attribute__((ext_vector_type(2)));

constexpr int M_TOK = 32768, SEQ = 4096;
constexpr float ALPHA = 1.41421356237f;
constexpr int LDS_XB = 153600;
constexpr int LDS_BYTES = LDS_XB + 16;

constexpr size_t MiB = 1u << 20;
constexpr size_t WS_WB = 0, WS_XB = 48 * MiB, WS_VF = 112 * MiB, WS_R = 144 * MiB, WS_END = 512 * MiB, WS_BAR = 47 * MiB + 512 * 1024;
constexpr size_t R_HB = 0, R_QKV = 0, R_U = 48 * MiB, R_VNEW = 48 * MiB, R_Y = 80 * MiB, R_ATT = 112 * MiB, R_CB = 144 * MiB,
                 R_R = 160 * MiB, R_K = 192 * MiB, R_V = 224 * MiB, R_AP = 256 * MiB, R_EW = 272 * MiB, R_A = 304 * MiB, R_G = 336 * MiB,
                 R_DEL = 176 * MiB, R_GA = 160 * MiB, R_GB = 256 * MiB, R_MB = 0;
constexpr size_t WB_GU0 = 0, WB_GU1 = 5767168, WB_D0 = 11534336, WB_D1 = 14417920, WB_IN = 17301504, WB_BA = 22020096, WB_BB = 22544384,
                 WB_O = 23068672, WB_LR = 24117248, WB_V12 = 24510464;

struct Params {
    const float* in[26];
    float* out;
    unsigned char* ws;
};

typedef __bf16 bf16x2_t __attribute__((ext_vector_type(2)));
typedef float f32x2_t __attribute__((ext_vector_type(2)));
__device__ __forceinline__ unsigned pk_bf16(float lo, float hi) { const f32x2_t f = {lo, hi}; return __builtin_bit_cast(unsigned, __builtin_convertvector(f, bf16x2_t)); }
__device__ __forceinline__ float bf_lo(unsigned w) { return __uint_as_float(w << 16); }
__device__ __forceinline__ float bf_hi(unsigned w) { return __uint_as_float(w & 0xffff0000u); }
__device__ __forceinline__ float bf2f(bf16_t b) { return __uint_as_float(((unsigned)b) << 16); }
__device__ __forceinline__ float sigm(float x) { return __builtin_amdgcn_rcpf(1.f + __expf(-x)); }
__device__ __forceinline__ int otid() { int t = threadIdx.x; asm volatile("" : "+v"(t)); return t; }
__device__ __forceinline__ int obid() { int b = blockIdx.x; asm volatile("" : "+s"(b)); return b; }
__device__ __forceinline__ float wave_sum(float x);
template <int CTRL> __device__ __forceinline__ float dpp_f(float x) { return __builtin_bit_cast(float, __builtin_amdgcn_mov_dpp(__builtin_bit_cast(int, x), CTRL, 0xF, 0xF, true)); }
__device__ __forceinline__ float row16_sum(float x) {
    x += dpp_f<0xB1>(x); x += dpp_f<0x4E>(x); x += dpp_f<0x141>(x); x += dpp_f<0x140>(x); return x;
}
__device__ __forceinline__ float row16_max(float x) {
    x = fmaxf(x, dpp_f<0xB1>(x)); x = fmaxf(x, dpp_f<0x4E>(x)); x = fmaxf(x, dpp_f<0x141>(x)); x = fmaxf(x, dpp_f<0x140>(x)); return x;
}
__device__ __forceinline__ float wave_sum(float x) {
    x = row16_sum(x);
    const int xi = __builtin_bit_cast(int, x);
    const float a = __builtin_bit_cast(float, __builtin_amdgcn_readlane(xi, 0)), b = __builtin_bit_cast(float, __builtin_amdgcn_readlane(xi, 16)),
                c = __builtin_bit_cast(float, __builtin_amdgcn_readlane(xi, 32)), d = __builtin_bit_cast(float, __builtin_amdgcn_readlane(xi, 48));
    return (a + b) + (c + d);
}

constexpr int BM = 256, BK = 64, HALF = 128, HTB = HALF * BK * 2, NXCD = 8, WGM = 8;
__device__ __forceinline__ int lds_byte(int r, int c) { const int st = (r >> 4) * 2 + (c >> 5), rr = r & 15, cc = c & 31, ob = rr * 64 + cc * 2; return st * 1024 + (ob ^ (((ob >> 9) & 1) << 5)); }
__device__ __forceinline__ void stage_rc(int b, int& R, int& C) { const int st = b / 1024, sb = b % 1024, swz = sb ^ (((sb >> 9) & 1) << 5); R = (st >> 1) * 16 + swz / 64; C = (st & 1) * 32 + (swz % 64) / 2; }
__device__ __forceinline__ int perm32(int rho) { const int n = rho >> 4, i = rho & 15; return 8 * (i >> 2) + 4 * n + (i & 3); }

struct Unit { int pm, pn; };
struct Gemm { const bf16_t* A; const bf16_t* Bt; int M, N, K; };
struct StaticOrder {
    int nM, nN, nwg, G, c;
    __device__ void init(int M, int N, int G_, int c_) { nM = M / BM; nN = N / BM; nwg = nM * nN; G = G_; c = c_; }
    __device__ bool next(int i, Unit& u) const {
        const long L = (long)i * G + c; if (L >= nwg) return false;
        int wgid = (int)L; { const int q = nwg / NXCD, r = nwg % NXCD, xcd = wgid % NXCD, off = wgid / NXCD; wgid = (xcd < r ? xcd * (q + 1) : r * (q + 1) + (xcd - r) * q) + off; }
        const int nig = WGM * nN, gid = wgid / nig, fm = gid * WGM, gsz = (nM - fm) < WGM ? (nM - fm) : WGM;
        u.pm = fm + ((wgid % nig) % gsz); u.pn = (wgid % nig) / gsz; return true;
    }
};

template <class Epi>
__device__ __forceinline__ void gemm_phase(LAS unsigned char* lds, const Gemm g, const Epi& E) {
    const int tid = otid(), wid = __builtin_amdgcn_readfirstlane(tid >> 6), lane = tid & 63, wr = wid >> 2, wc = wid & 3, fr = lane & 15, fq = lane >> 4;
    int Kop = g.K; asm volatile("" : "+s"(Kop));
    const int K = Kop, nt = K / BK;
    StaticOrder S; S.init(g.M, g.N, (int)gridDim.x, obid());
    unsigned voffA[2], voffB[2];
#pragma unroll
    for (int i = 0; i < 2; ++i) { int R, C; stage_rc(tid * 16 + i * 8192, R, C); const int Rb = Epi::PERM ? ((R & ~31) + perm32(R & 31)) : R;
        voffA[i] = (unsigned)(R * K + C) * 2u; voffB[i] = (unsigned)(Rb * K + C) * 2u; }
    const size_t kstep = (size_t)(BK * 2);
    const size_t hstep = (size_t)HALF * K * 2;
    const size_t tstep = 2 * hstep;
    const unsigned ldsw = (unsigned)wid * 1024u;
    const int aoff = lds_byte(wr * 64 + fr, fq * 8), boff = lds_byte(wc * 32 + fr, fq * 8);
#define PG8_SA(b, h) (((b) * 2 + (h)) * HTB)
#define PG8_SB(b, h) ((4 + (b) * 2 + (h)) * HTB)
#define PG8_STAGE(bufoff, gbase, voff) do { _Pragma("unroll") for (int _i = 0; _i < 2; ++_i) \
        __builtin_amdgcn_global_load_lds((const unsigned*)((const char*)(gbase) + (voff)[_i]), (LAS unsigned*)(lds + (bufoff) + ldsw + _i * 8192), 16, 0, 0); } while (0)
#define PG8_LDA(dst, b, h) do { _Pragma("unroll") for (int m = 0; m < 4; ++m) _Pragma("unroll") for (int k = 0; k < 2; ++k) dst[m][k] = *(const LAS bf16x8*)(lds + PG8_SA(b, h) + aoff + m * 2048 + k * 1024); } while (0)
#define PG8_LDB(dst, b, h) do { _Pragma("unroll") for (int n = 0; n < 2; ++n) _Pragma("unroll") for (int k = 0; k < 2; ++k) dst[n][k] = *(const LAS bf16x8*)(lds + PG8_SB(b, h) + boff + n * 2048 + k * 1024); } while (0)
#define PG8_MMA(ai, bj, At, Bt) do { __builtin_amdgcn_s_setprio(1); _Pragma("unroll") for (int m = 0; m < 4; ++m) _Pragma("unroll") for (int n = 0; n < 2; ++n) _Pragma("unroll") for (int k = 0; k < 2; ++k) \
        acc[ai][bj][m][n] = __builtin_amdgcn_mfma_f32_16x16x32_bf16(Bt[n][k], At[m][k], acc[ai][bj][m][n], 0, 0, 0); __builtin_amdgcn_s_setprio(0); } while (0)
#define PG8_WAIT_V(n) asm volatile("s_waitcnt vmcnt(" #n ")" ::: "memory")
#define PG8_WAIT_L(n) asm volatile("s_waitcnt lgkmcnt(" #n ")" ::: "memory")
#define PG8_BAR __builtin_amdgcn_s_barrier()
#define PG8_SCHED __builtin_amdgcn_sched_barrier(0)
    Unit cur, nxt; int ui = 0;
    if (!S.next(0, cur)) return;
    f32x4 acc[2][2][4][2];
#pragma unroll
    for (int a = 0; a < 2; ++a)
#pragma unroll
        for (int b = 0; b < 2; ++b)
#pragma unroll
            for (int m = 0; m < 4; ++m)
#pragma unroll
                for (int n = 0; n < 2; ++n) acc[a][b][m][n] = (f32x4){0.f, 0.f, 0.f, 0.f};
    bf16x8 At[4][2], B0[2][2], B1[2][2];
    const char* cA = (const char*)g.A + (size_t)cur.pm * tstep; const char* cB = (const char*)g.Bt + (size_t)cur.pn * tstep;
    PG8_STAGE(PG8_SB(0, 0), cB, voffB); PG8_STAGE(PG8_SA(0, 0), cA, voffA); PG8_STAGE(PG8_SB(0, 1), cB + hstep, voffB); PG8_STAGE(PG8_SA(0, 1), cA + hstep, voffA);
    if (wr == 1) PG8_BAR;
    PG8_WAIT_V(4); PG8_BAR;
    PG8_STAGE(PG8_SB(1, 0), cB + kstep, voffB); PG8_STAGE(PG8_SA(1, 0), cA + kstep, voffA); PG8_STAGE(PG8_SB(1, 1), cB + hstep + kstep, voffB);
    PG8_WAIT_V(6); PG8_BAR;
    for (;;) {
        const bool has_next = S.next(ui + 1, nxt);
        const char* nA = has_next ? (const char*)g.A + (size_t)nxt.pm * tstep : cA; const char* nB = has_next ? (const char*)g.Bt + (size_t)nxt.pn * tstep : cB;
#pragma unroll 1
        for (int t = 0; t < nt; t += 2) {
            const bool last = (t == nt - 2);
            const char* a1 = cA + (size_t)(t + 1) * kstep;
            const char* a2 = last ? nA : cA + (size_t)(t + 2) * kstep; const char* b2 = last ? nB : cB + (size_t)(t + 2) * kstep;
            const char* a3 = a2 + kstep; const char* b3 = b2 + kstep;
            PG8_LDB(B0, 0, 0); PG8_SCHED; PG8_LDA(At, 0, 0); PG8_STAGE(PG8_SA(1, 1), a1 + hstep, voffA);
            PG8_WAIT_L(8); PG8_BAR; PG8_WAIT_L(0); PG8_MMA(0, 0, At, B0); PG8_BAR; PG8_SCHED;
            PG8_LDB(B1, 0, 1); PG8_STAGE(PG8_SB(0, 0), b2, voffB);
            PG8_BAR; PG8_WAIT_L(0); PG8_MMA(0, 1, At, B1); PG8_BAR;
            PG8_LDA(At, 0, 1); PG8_STAGE(PG8_SA(0, 0), a2, voffA);
            PG8_BAR; PG8_WAIT_L(0); PG8_MMA(1, 0, At, B0); PG8_BAR; PG8_SCHED;
            PG8_STAGE(PG8_SB(0, 1), b2 + hstep, voffB);
            PG8_WAIT_V(6); PG8_BAR; PG8_MMA(1, 1, At, B1); PG8_BAR;
            PG8_LDB(B0, 1, 0); PG8_SCHED; PG8_LDA(At, 1, 0); PG8_STAGE(PG8_SA(0, 1), a2 + hstep, voffA);
            PG8_WAIT_L(8); PG8_BAR; PG8_WAIT_L(0); PG8_MMA(0, 0, At, B0); PG8_BAR; PG8_SCHED;
            PG8_LDB(B1, 1, 1); PG8_STAGE(PG8_SB(1, 0), b3, voffB);
            PG8_BAR; PG8_WAIT_L(0); PG8_MMA(0, 1, At, B1); PG8_BAR;
            PG8_LDA(At, 1, 1); PG8_STAGE(PG8_SA(1, 0), a3, voffA);
            PG8_BAR; PG8_WAIT_L(0); PG8_MMA(1, 0, At, B0); PG8_BAR; PG8_SCHED;
            PG8_STAGE(PG8_SB(1, 1), b3 + hstep, voffB);
            PG8_WAIT_V(6); PG8_BAR; PG8_MMA(1, 1, At, B1); PG8_BAR;
        }
        { int fr2 = fr, fq2 = fq; asm volatile("" : "+v"(fr2), "+v"(fq2)); E(acc, cur, wr, wc, fr2, fq2); }
        if (!has_next) break;
#pragma unroll
        for (int a = 0; a < 2; ++a)
#pragma unroll
            for (int b = 0; b < 2; ++b)
#pragma unroll
                for (int m = 0; m < 4; ++m)
#pragma unroll
                    for (int n = 0; n < 2; ++n) acc[a][b][m][n] = (f32x4){0.f, 0.f, 0.f, 0.f};
        cur = nxt; cA = nA; cB = nB; ++ui;
    }
    PG8_WAIT_V(0);
    if (wr == 0) PG8_BAR;
    PG8_BAR;
#undef PG8_SA
#undef PG8_SB
#undef PG8_STAGE
#undef PG8_LDA
#undef PG8_LDB
#undef PG8_MMA
#undef PG8_WAIT_V
#undef PG8_WAIT_L
#undef PG8_BAR
#undef PG8_SCHED
}

struct EpiGU {
    static constexpr bool PERM = false;
    bf16_t* H;
    __device__ __forceinline__ void operator()(const f32x4 (&acc)[2][2][4][2], const Unit& u, int wr, int wc, int fr, int fq) const {
        const int row0 = u.pm * BM + wr * 64 + fr, col0 = u.pn * 128 + wc * 32 + fq * 8;
#pragma unroll
        for (int ai = 0; ai < 2; ++ai)
#pragma unroll
            for (int m = 0; m < 4; ++m) {
                float h[8];
#pragma unroll
                for (int bj = 0; bj < 2; ++bj)
#pragma unroll
                    for (int j = 0; j < 4; ++j) { const float gt = acc[ai][bj][m][0][j], up = acc[ai][bj][m][1][j]; h[bj * 4 + j] = gt * sigm(gt) * up; }
                u32x4 w; w.x = pk_bf16(h[0], h[1]); w.y = pk_bf16(h[2], h[3]); w.z = pk_bf16(h[4], h[5]); w.w = pk_bf16(h[6], h[7]);
                *(u32x4*)(H + (size_t)(row0 + ai * HALF + m * 16) * 2816 + col0) = w;
            }
    }
};
struct EpiRes {
    static constexpr bool PERM = false;
    const float* res; float* out; float alpha, beta;
    __device__ __forceinline__ void operator()(const f32x4 (&acc)[2][2][4][2], const Unit& u, int wr, int wc, int fr, int fq) const {
        const int row0 = u.pm * BM + wr * 64 + fr, col0 = u.pn * BM + wc * 32 + 4 * fq;
#pragma unroll
        for (int ai = 0; ai < 2; ++ai)
#pragma unroll
            for (int mp = 0; mp < 2; ++mp) {
                f32x4 x[2][2][2];
#pragma unroll
                for (int mm = 0; mm < 2; ++mm)
#pragma unroll
                    for (int bj = 0; bj < 2; ++bj)
#pragma unroll
                        for (int n = 0; n < 2; ++n) x[mm][bj][n] = *(const f32x4*)(res + (size_t)(row0 + ai * HALF + (mp * 2 + mm) * 16) * 1024 + col0 + bj * HALF + n * 16);
#pragma unroll
                for (int mm = 0; mm < 2; ++mm)
#pragma unroll
                    for (int bj = 0; bj < 2; ++bj)
#pragma unroll
                        for (int n = 0; n < 2; ++n) *(f32x4*)(out + (size_t)(row0 + ai * HALF + (mp * 2 + mm) * 16) * 1024 + col0 + bj * HALF + n * 16) = x[mm][bj][n] * alpha + acc[ai][bj][mp * 2 + mm][n] * beta;
            }
    }
};
template <class F> struct EpiP {
    static constexpr bool PERM = true;
    F f;
    __device__ __forceinline__ void operator()(const f32x4 (&acc)[2][2][4][2], const Unit& u, int wr, int wc, int fr, int fq) const {
        const int row0 = u.pm * BM + wr * 64 + fr, cb0 = u.pn * BM + wc * 32 + 8 * fq;
        typename F::Col cv[2];
#pragma unroll
        for (int bj = 0; bj < 2; ++bj) cv[bj] = f.col(cb0 + bj * HALF, u.pn);
#pragma unroll
        for (int ai = 0; ai < 2; ++ai)
#pragma unroll
          for (int mp = 0; mp < 2; ++mp) {
            typename F::Pos pv[2][2];
#pragma unroll
            for (int mm = 0; mm < 2; ++mm)
#pragma unroll
                for (int bj = 0; bj < 2; ++bj) pv[mm][bj] = f.pos(row0 + ai * HALF + (mp * 2 + mm) * 16, cb0 + bj * HALF, u.pn);
#pragma unroll
            for (int mm = 0; mm < 2; ++mm)
#pragma unroll
                for (int bj = 0; bj < 2; ++bj) f.fin(row0 + ai * HALF + (mp * 2 + mm) * 16, cb0 + bj * HALF, acc[ai][bj][mp * 2 + mm][0], acc[ai][bj][mp * 2 + mm][1], u.pn, cv[bj], pv[mm][bj]);
          }
    }
};
struct Col8 { f32x4 a, b; };
struct None {};
__device__ __forceinline__ u32x4 pack8(const f32x4 a, const f32x4 b) { u32x4 w; w.x = pk_bf16(a[0], a[1]); w.y = pk_bf16(a[2], a[3]); w.z = pk_bf16(b[0], b[1]); w.w = pk_bf16(b[2], b[3]); return w; }
__device__ __forceinline__ void unpack8(const u32x4 w, f32x4& a, f32x4& b) { a[0] = bf_lo(w.x); a[1] = bf_hi(w.x); a[2] = bf_lo(w.y); a[3] = bf_hi(w.y); b[0] = bf_lo(w.z); b[1] = bf_hi(w.z); b[2] = bf_lo(w.w); b[3] = bf_hi(w.w); }
__device__ __forceinline__ f32x4 sigm4(const f32x4 x) { f32x4 r; r[0] = sigm(x[0]); r[1] = sigm(x[1]); r[2] = sigm(x[2]); r[3] = sigm(x[3]); return r; }

struct FProj {
    typedef Col8 Col; typedef None Pos;
    bf16_t* QKV; bf16_t* U; const float* bias;
    __device__ __forceinline__ Col col(int cb, int) const { Col c; c.a = *(const f32x4*)(bias + cb); c.b = *(const f32x4*)(bias + cb + 4); return c; }
    __device__ __forceinline__ Pos pos(int, int, int) const { return None{}; }
    __device__ __forceinline__ void fin(int row, int cb, f32x4 v0, f32x4 v1, int pn, const Col& c, const Pos&) const {
        bf16_t* dst = (pn < 3) ? (QKV + (size_t)row * 768 + cb) : (U + (size_t)row * 1792 + (cb - 768));
        *(u32x4*)dst = pack8(v0 + c.a, v1 + c.b);
    }
};
struct FLowRank {
    typedef Col8 Col; typedef None Pos;
    _Float16* EW; bf16_t* A; bf16_t* G; const float* w0; const float* a0;
    __device__ __forceinline__ Col col(int cb, int pn) const { Col c; const float* src = (pn < 2) ? (w0 + cb) : (a0 + ((cb - 512) & 511)); c.a = *(const f32x4*)src; c.b = *(const f32x4*)(src + 4); return c; }
    __device__ __forceinline__ Pos pos(int, int, int) const { return None{}; }
    __device__ __forceinline__ void fin(int row, int cb, f32x4 v0, f32x4 v1, int pn, const Col& c, const Pos&) const {
        if (pn < 2) {
            v0 = sigm4(v0 + c.a) * 0.60653065971f; v1 = sigm4(v1 + c.b) * 0.60653065971f;
            typedef _Float16 h8 __attribute__((ext_vector_type(8)));
            h8 o; o[0] = (_Float16)v0[0]; o[1] = (_Float16)v0[1]; o[2] = (_Float16)v0[2]; o[3] = (_Float16)v0[3]; o[4] = (_Float16)v1[0]; o[5] = (_Float16)v1[1]; o[6] = (_Float16)v1[2]; o[7] = (_Float16)v1[3];
            *(h8*)(EW + (size_t)row * 512 + cb) = o;
        } else if (pn < 4) {
            *(u32x4*)(A + (size_t)row * 512 + (cb - 512)) = pack8(sigm4(v0 + c.a), sigm4(v1 + c.b));
        } else {
            *(u32x4*)(G + (size_t)row * 512 + (cb - 1024)) = pack8(v0, v1);
        }
    }
};
struct FDelta {
    typedef None Col; typedef None Pos;
    bf16_t* D; float beta;
    __device__ __forceinline__ Col col(int, int) const { return None{}; }
    __device__ __forceinline__ Pos pos(int, int, int) const { return None{}; }
    __device__ __forceinline__ void fin(int row, int cb, f32x4 v0, f32x4 v1, int, const Col&, const Pos&) const {
        *(u32x4*)(D + (size_t)row * 1024 + cb) = pack8(v0 * beta, v1 * beta);
    }
};
struct Pos2 { u32x4 a, b; };
struct FVmix {
    typedef Col8 Col; typedef Pos2 Pos;
    const bf16_t* V; const bf16_t* VF; bf16_t* VN; const float* v0p;
    __device__ __forceinline__ Col col(int cb, int) const { Col c; c.a = *(const f32x4*)(v0p + cb); c.b = *(const f32x4*)(v0p + cb + 4); return c; }
    __device__ __forceinline__ Pos pos(int row, int cb, int) const { Pos q; q.a = *(const u32x4*)(V + (size_t)row * 512 + cb); q.b = *(const u32x4*)(VF + (size_t)row * 512 + cb); return q; }
    __device__ __forceinline__ void fin(int row, int cb, f32x4 v0, f32x4 v1, int, const Col& c, const Pos& q) const {
        const f32x4 s0 = sigm4(v0 + c.a), s1 = sigm4(v1 + c.b);
        f32x4 a0, a1, f0, f1; unpack8(q.a, a0, a1); unpack8(q.b, f0, f1);
        *(u32x4*)(VN + (size_t)row * 512 + cb) = pack8(a0 + (f0 - a0) * s0, a1 + (f1 - a1) * s1);
    }
};
struct FGates {
    typedef Col8 Col; typedef None Pos;
    bf16_t* GA; bf16_t* GB; const float* bias;
    __device__ __forceinline__ Col col(int cb, int) const { Col c; c.a = *(const f32x4*)(bias + cb); c.b = *(const f32x4*)(bias + cb + 4); return c; }
    __device__ __forceinline__ Pos pos(int, int, int) const { return None{}; }
    __device__ __forceinline__ void fin(int row, int cb, f32x4 v0, f32x4 v1, int pn, const Col& c, const Pos&) const {
        bf16_t* dst = (pn < 4) ? (GA + (size_t)row * 1024 + cb) : (GB + (size_t)row * 1024 + (cb - 1024));
        *(u32x4*)dst = pack8(sigm4(v0 + c.a), sigm4(v1 + c.b));
    }
};
template <bool ADD> struct FBranch {
    typedef None Col; typedef Pos2 Pos;
    const bf16_t* GT; bf16_t* MB;
    __device__ __forceinline__ Col col(int, int) const { return None{}; }
    __device__ __forceinline__ Pos pos(int row, int cb, int) const { Pos q; q.a = *(const u32x4*)(GT + (size_t)row * 1024 + cb); q.b = ADD ? *(const u32x4*)(MB + (size_t)row * 1024 + cb) : (u32x4){0u, 0u, 0u, 0u}; return q; }
    __device__ __forceinline__ void fin(int row, int cb, f32x4 v0, f32x4 v1, int, const Col&, const Pos& q) const {
        f32x4 g0, g1; unpack8(q.a, g0, g1);
        f32x4 r0 = g0 * v0, r1 = g1 * v1;
        if (ADD) { f32x4 m0, m1; unpack8(q.b, m0, m1); r0 += m0; r1 += m1; }
        *(u32x4*)(MB + (size_t)row * 1024 + cb) = pack8(r0, r1);
    }
};

__device__ __forceinline__ int gu_row(int c) {
    const int nn = c >= 2816 ? 1 : 0, hc = c - 2816 * nn, pn = hc >> 7, rem = hc & 127, wc = rem >> 5, r5 = rem & 31, ih = r5 >> 3, bj = (r5 >> 2) & 1, il = r5 & 3;
    return 256 * pn + bj * 128 + wc * 32 + nn * 16 + ih * 4 + il;
}
__device__ __forceinline__ void wtrans(const float* __restrict__ src, int K, int N, bf16_t* __restrict__ dst, int ldd, int mode, LAS float* tile) {
    const int tid = otid(), tn = N >> 6, nt = (K >> 6) * tn;
    for (int t = obid(); t < nt; t += gridDim.x) {
        const int k0 = (t / tn) << 6, c0 = (t % tn) << 6;
        {
#pragma unroll
          for (int i = 0; i < 2; ++i) { const int e = tid + 512 * i, kl = e >> 4, c4 = (e & 15) * 4;
              const f32x4 v4 = *(const f32x4*)(src + (size_t)(k0 + kl) * N + c0 + c4);
              tile[kl * 65 + c4] = v4[0]; tile[kl * 65 + c4 + 1] = v4[1]; tile[kl * 65 + c4 + 2] = v4[2]; tile[kl * 65 + c4 + 3] = v4[3]; } }
        __syncthreads();
        { const int kp = tid & 31, cl0 = tid >> 5;
#pragma unroll
          for (int i = 0; i < 4; ++i) { const int cl = cl0 + 16 * i, c = c0 + cl; const int R = mode ? gu_row(c) : c;
              *(unsigned*)(dst + (size_t)R * ldd + k0 + 2 * kp) = pk_bf16(tile[(2 * kp) * 65 + cl], tile[(2 * kp + 1) * 65 + cl]); } }
        __syncthreads();
    }
}
__device__ __forceinline__ void phase_wprep(const Params& p, int l, LAS float* tile) {
    bf16_t* WB = (bf16_t*)(p.ws + WS_WB);
    wtrans(p.in[1] + (size_t)(l * 2 + 0) * 1024 * 5632, 1024, 5632, WB + WB_GU0, 1024, 1, tile);
    wtrans(p.in[1] + (size_t)(l * 2 + 1) * 1024 * 5632, 1024, 5632, WB + WB_GU1, 1024, 1, tile);
    wtrans(p.in[2] + (size_t)(l * 2 + 0) * 2816 * 1024, 2816, 1024, WB + WB_D0, 2816, 0, tile);
    wtrans(p.in[2] + (size_t)(l * 2 + 1) * 2816 * 1024, 2816, 1024, WB + WB_D1, 2816, 0, tile);
    wtrans(p.in[5] + (size_t)l * 1024 * 4608, 1024, 4608, WB + WB_IN, 1024, 0, tile);
    wtrans(p.in[23] + (size_t)l * 512 * 1024, 512, 1024, WB + WB_BA, 512, 0, tile);
    wtrans(p.in[24] + (size_t)l * 512 * 1024, 512, 1024, WB + WB_BB, 512, 0, tile);
    wtrans(p.in[25] + (size_t)l * 1024 * 1024, 1024, 1024, WB + WB_O, 1024, 0, tile);
    const int gt = obid() * 512 + otid(), nth = gridDim.x * 512;
    {
        const float* w2 = p.in[11] + (size_t)l * 64 * 512; const float* a2 = p.in[13] + (size_t)l * 64 * 512; const float* g2 = p.in[14] + (size_t)l * 128 * 512;
        for (int idx = gt; idx < 1536 * 256; idx += nth) { const int n = idx >> 8, k = idx & 255; float v = 0.f;
            if (n < 512) { if (k < 64) v = w2[k * 512 + n]; }
            else if (n < 1024) { if (k >= 64 && k < 128) v = a2[(k - 64) * 512 + (n - 512)]; }
            else { if (k >= 128) v = g2[(k - 128) * 512 + (n - 1024)]; }
            WB[WB_LR + idx] = (bf16_t)(pk_bf16(v, 0.f) & 0xffffu); }
    }
    if (l >= 1) {
        const float* v1 = p.in[21] + (size_t)(l - 1) * 512 * 32; const float* v2 = p.in[22] + (size_t)(l - 1) * 32 * 512;
        for (int idx = gt; idx < 512 * 512; idx += nth) { const int n = idx >> 9, k = idx & 511; float s = 0.f;
#pragma unroll 8
            for (int r = 0; r < 32; ++r) s += v1[k * 32 + r] * v2[r * 512 + n];
            WB[WB_V12 + idx] = (bf16_t)(pk_bf16(s, 0.f) & 0xffffu); }
    }
}
__device__ __forceinline__ void phase_cvt_x(const Params& p) {
    const float* x = p.in[0]; bf16_t* XB = (bf16_t*)(p.ws + WS_XB);
    const size_t n8 = (size_t)M_TOK * 1024 / 8;
    for (size_t i = (size_t)obid() * 512 + otid(); i < n8; i += (size_t)gridDim.x * 512) {
        const f32x4 a = *(const f32x4*)(x + i * 8), b = *(const f32x4*)(x + i * 8 + 4);
        *(u32x4*)(XB + i * 8) = pack8(a, b);
    }
}

__device__ __forceinline__ void phase_ln(const float* RES, const bf16_t* DEL, float* X, bf16_t* XB, const float* g, const float* b, bool write_xb) {
    const int tid = otid(), wid = tid >> 6, lane = tid & 63;
    const int nw = gridDim.x * 8, w0 = obid() * 8 + wid;
    for (int base = w0; base < M_TOK; base += nw * 4) {
        f32x4 v[4][4];
#pragma unroll
        for (int r = 0; r < 4; ++r) { const float* xr = RES + (size_t)(base + r * nw) * 1024; const bf16_t* dr = DEL + (size_t)(base + r * nw) * 1024;
#pragma unroll
            for (int i = 0; i < 2; ++i) { const int c = i * 512 + lane * 8; const f32x4 xa = *(const f32x4*)(xr + c), xb2 = *(const f32x4*)(xr + c + 4); const u32x4 d4 = *(const u32x4*)(dr + c);
                f32x4 da, db; unpack8(d4, da, db); v[r][2 * i] = xa * ALPHA + da; v[r][2 * i + 1] = xb2 * ALPHA + db; } }
        float mean[4], rs[4];
#pragma unroll
        for (int r = 0; r < 4; ++r) { float s = 0.f;
#pragma unroll
            for (int i = 0; i < 4; ++i) s += v[r][i][0] + v[r][i][1] + v[r][i][2] + v[r][i][3];
            mean[r] = wave_sum(s) * (1.f / 1024.f); }
#pragma unroll
        for (int r = 0; r < 4; ++r) { float q = 0.f;
#pragma unroll
            for (int i = 0; i < 4; ++i) { v[r][i] -= mean[r]; q += v[r][i][0] * v[r][i][0] + v[r][i][1] * v[r][i][1] + v[r][i][2] * v[r][i][2] + v[r][i][3] * v[r][i][3]; }
            rs[r] = rsqrtf(wave_sum(q) * (1.f / 1024.f) + 1e-5f); }
#pragma unroll
        for (int i = 0; i < 2; ++i) { const int c = i * 512 + lane * 8;
            const f32x4 ga = *(const f32x4*)(g + c), gb = *(const f32x4*)(g + c + 4), ba = *(const f32x4*)(b + c), bb = *(const f32x4*)(b + c + 4);
#pragma unroll
            for (int r = 0; r < 4; ++r) { const size_t ro = (size_t)(base + r * nw) * 1024 + c;
                const f32x4 oa = v[r][2 * i] * rs[r] * ga + ba, ob = v[r][2 * i + 1] * rs[r] * gb + bb;
                *(f32x4*)(X + ro) = oa; *(f32x4*)(X + ro + 4) = ob;
                if (write_xb) *(u32x4*)(XB + ro) = pack8(oa, ob); } }
    }
}

__device__ __forceinline__ void phase_prep(const Params& p, int l) {
    unsigned char* R = p.ws + WS_R;
    const bf16_t* U = (const bf16_t*)(R + R_U); bf16_t* Rb = (bf16_t*)(R + R_R); bf16_t* Kb = (bf16_t*)(R + R_K); bf16_t* Vb = (bf16_t*)(R + R_V); bf16_t* AP = (bf16_t*)(R + R_AP);
    bf16_t* VF = (bf16_t*)(p.ws + WS_VF);
    const float* mu = p.in[9] + (size_t)l * 1792;
    const int tid = otid(), wid = tid >> 6, lane = tid & 63;
    const bool has3 = lane < 32;
    f32x4 m0[4], m1[4];
#pragma unroll
    for (int i = 0; i < 4; ++i) { const int c = (i < 3 || has3) ? (lane + 64 * i) * 8 : 0; m0[i] = *(const f32x4*)(mu + c); m1[i] = *(const f32x4*)(mu + c + 4); }
    for (int wv = obid() * 8 + wid; wv < M_TOK / 16; wv += gridDim.x * 8) {
        const int row0 = wv * 16;
        u32x4 prv[4], cur[4];
#pragma unroll
        for (int i = 0; i < 4; ++i) { prv[i] = (u32x4){0u, 0u, 0u, 0u}; cur[i] = prv[i]; }
        if ((row0 & (SEQ - 1)) != 0) {
#pragma unroll
            for (int i = 0; i < 4; ++i) if (i < 3 || has3) prv[i] = *(const u32x4*)(U + (size_t)(row0 - 1) * 1792 + (lane + 64 * i) * 8);
        }
#pragma unroll
        for (int i = 0; i < 4; ++i) if (i < 3 || has3) cur[i] = *(const u32x4*)(U + (size_t)row0 * 1792 + (lane + 64 * i) * 8);
#pragma unroll 2
        for (int r = 0; r < 16; ++r) {
            const int row = row0 + r;
            u32x4 nxt[4];
#pragma unroll
            for (int i = 0; i < 4; ++i) { nxt[i] = (u32x4){0u, 0u, 0u, 0u}; if (r < 15 && (i < 3 || has3)) nxt[i] = *(const u32x4*)(U + (size_t)(row + 1) * 1792 + (lane + 64 * i) * 8); }
#pragma unroll
            for (int i = 0; i < 4; ++i) {
                f32x4 c0v, c1v, p0v, p1v; unpack8(cur[i], c0v, c1v); unpack8(prv[i], p0v, p1v);
                f32x4 u0 = c0v + (p0v - c0v) * m0[i], u1 = c1v + (p1v - c1v) * m1[i];
                if (i == 0) *(u32x4*)(Rb + (size_t)row * 512 + lane * 8) = pack8(u0, u1);
                else if (i == 1) *(u32x4*)(Kb + (size_t)row * 512 + lane * 8) = pack8(u0, u1);
                else if (i == 2) { const u32x4 w = pack8(u0, u1); *(u32x4*)(Vb + (size_t)row * 512 + lane * 8) = w; if (l == 0) *(u32x4*)(VF + (size_t)row * 512 + lane * 8) = w; }
                else if (has3) {
                    if (lane < 8) {
#pragma unroll
                        for (int j = 0; j < 4; ++j) { u0[j] = 1.f - 2.f * __builtin_amdgcn_rcpf(__expf(2.f * u0[j]) + 1.f); u1[j] = 1.f - 2.f * __builtin_amdgcn_rcpf(__expf(2.f * u1[j]) + 1.f); }
                    } else if (lane >= 16) { u0 = sigm4(u0); u1 = sigm4(u1); }
                    *(u32x4*)(AP + (size_t)row * 256 + lane * 8) = pack8(u0, u1);
                }
            }
#pragma unroll
            for (int i = 0; i < 4; ++i) { prv[i] = cur[i]; cur[i] = nxt[i]; }
        }
    }
}

__device__ __forceinline__ void lds_barrier() { asm volatile("s_waitcnt lgkmcnt(0)" ::: "memory"); __builtin_amdgcn_s_barrier(); asm volatile("" ::: "memory"); }
constexpr int SC_SLOT = 12288, SC_AT = 0, SC_RT = 2048, SC_BBT = 4096, SC_KBT = 6656, SC_AK = 9216, SC_X = 9728, SC_RB = 10240, SC_RK = 10752, SC_VP = 11264, SC_WC = 11776;
constexpr int SC_BS = 20;
constexpr int SC_NP = 5, SC_RING = 2 * SC_NP * SC_SLOT, SC_SCR = 6144;
__device__ __forceinline__ bf16x8 frag4(LAS const unsigned char* p) { const u32x2 w = *(LAS const u32x2*)p; return __builtin_bit_cast(bf16x8, (u32x4){w.x, w.y, 0u, 0u}); }
__device__ __forceinline__ bf16x8 cfrag(const f32x4 c) { return __builtin_bit_cast(bf16x8, (u32x4){pk_bf16(c[0], c[1]), pk_bf16(c[2], c[3]), 0u, 0u}); }
__device__ __forceinline__ bf16_t bf1(float x) { return (bf16_t)(pk_bf16(x, 0.f) & 0xffffu); }
__device__ __forceinline__ float wave_sum64(float x) { x = row16_sum(x); x += __shfl_xor(x, 16); x += __shfl_xor(x, 32); return x; }
__device__ __forceinline__ void st_mat(LAS unsigned char* rm, LAS unsigned char* tr, LAS unsigned char* trI, LAS unsigned char* rmI, const f32x4 c, int fr, int fq) {
#pragma unroll
    for (int r = 0; r < 4; ++r) { const int t = 4 * fq + r; const float v = c[r], vi = v + (t == fr ? 1.f : 0.f);
        if (rm) *(LAS bf16_t*)(rm + (t * 16 + fr) * 2) = bf1(v);
        if (tr) *(LAS bf16_t*)(tr + (fr * 16 + t) * 2) = bf1(v);
        if (trI) *(LAS bf16_t*)(trI + (fr * 16 + t) * 2) = bf1(vi);
        if (rmI) *(LAS bf16_t*)(rmI + (t * 16 + fr) * 2) = bf1(vi); }
}
__device__ __forceinline__ f32x4 mm16(LAS const unsigned char* Arm, LAS const unsigned char* Btr, int fr, int fq) {
    asm volatile("s_waitcnt lgkmcnt(0)" ::: "memory");
    const bf16x8 a = frag4(Arm + (fr * 16 + 4 * fq) * 2), b = frag4(Btr + (fr * 16 + 4 * fq) * 2);
    return __builtin_amdgcn_mfma_f32_16x16x32_bf16(a, b, (f32x4){0.f, 0.f, 0.f, 0.f}, 0, 0, 0);
}
__device__ __forceinline__ void phase_scan2(const Params& p, int l, LAS unsigned char* lds) {
    unsigned char* R = p.ws + WS_R;
    const bf16_t* Rb = (const bf16_t*)(R + R_R); const bf16_t* Kb = (const bf16_t*)(R + R_K); const bf16_t* Vb = (const bf16_t*)(R + (l == 0 ? R_V : R_VNEW));
    const bf16_t* Ab = (const bf16_t*)(R + R_A); const _Float16* EW = (const _Float16*)(R + R_EW);
    bf16_t* Y = (bf16_t*)(R + R_Y); float* CB = (float*)(R + R_CB);
    const float* k_k = p.in[15] + (size_t)l * 512; const float* k_a = p.in[16] + (size_t)l * 512; const float* r_k = p.in[17] + (size_t)l * 512;
    const int tid = otid(), wid = tid >> 6, lane = tid & 63, fr = lane & 15, fq = lane >> 4;
    constexpr int NCH = SEQ / 16, NRD = (NCH + SC_NP - 1) / SC_NP;
    for (int job = obid(); job < 256; job += gridDim.x) {
        const int bh = job >> 2, rg = job & 3, b = bh >> 3, h = bh & 7;
        const size_t tok0 = (size_t)b * SEQ;
        const int pw = wid - 3, j = lane;
        const float kkc = k_k[h * 64 + j], kac = k_a[h * 64 + j], rkc = r_k[h * 64 + j];
        unsigned short kraw[16], araw[16], rraw[16]; _Float16 eraw[16]; unsigned short vraw[4];
#pragma unroll
        for (int t = 0; t < 16; ++t) { kraw[t] = 0; araw[t] = 0; rraw[t] = 0; eraw[t] = (_Float16)0; }
#pragma unroll
        for (int q = 0; q < 4; ++q) vraw[q] = 0;
        auto pload = [&](int c) {
            const size_t base = (tok0 + (size_t)c * 16) * 512 + h * 64;
#pragma unroll
            for (int t = 0; t < 16; ++t) { const size_t off = base + (size_t)t * 512 + j; kraw[t] = Kb[off]; araw[t] = Ab[off]; rraw[t] = Rb[off]; eraw[t] = EW[off]; }
#pragma unroll
            for (int q = 0; q < 4; ++q) vraw[q] = Vb[base + (size_t)(4 * fq + q) * 512 + rg * 16 + fr];
        };
        auto pbuild = [&](int c, LAS unsigned char* sl, LAS unsigned char* sc, int cnext) {
            float W = 1.f;
            const int m = j >> 5, tp = (j >> 4) & 1, jw = j & 15, pidx = (jw >> 2) * 8 + tp * 4 + (jw & 3);
#pragma unroll
            for (int t = 0; t < 16; ++t) {
                const float k = bf2f(kraw[t]), a = bf2f(araw[t]), r = bf2f(rraw[t]);
                const float q = k * kkc, kp1 = k * (1.f + (a - 1.f) * kac);
                *(LAS bf16_t*)(sc + 0 + (t * 64 + j) * 2) = bf1(q * q);
                *(LAS bf16_t*)(sc + 2048 + (t * 64 + j) * 2) = bf1(r * kp1 * rkc);
            }
            asm volatile("s_waitcnt lgkmcnt(0)" ::: "memory");
            { const bf16x8 ones = __builtin_bit_cast(bf16x8, (u32x4){0x3F803F80u, 0x3F803F80u, 0x3F803F80u, 0x3F803F80u});
              f32x4 sq = (f32x4){0.f, 0.f, 0.f, 0.f}, sb = sq;
#pragma unroll
              for (int kk2 = 0; kk2 < 2; ++kk2) {
                  const bf16x8 fa = *(LAS const bf16x8*)(sc + 0 + (fr * 64 + kk2 * 32 + fq * 8) * 2), fu = *(LAS const bf16x8*)(sc + 2048 + (fr * 64 + kk2 * 32 + fq * 8) * 2);
                  sq = __builtin_amdgcn_mfma_f32_16x16x32_bf16(fa, ones, sq, 0, 0, 0); sb = __builtin_amdgcn_mfma_f32_16x16x32_bf16(fu, ones, sb, 0, 0, 0);
              }
              if (fr == 0) { *(LAS f32x4*)(sl + SC_X + fq * 16) = sq; *(LAS f32x4*)(sl + SC_X + 64 + fq * 16) = sb; }
              asm volatile("s_waitcnt lgkmcnt(0)" ::: "memory");
              if (rg == 0 && lane < 16) CB[(tok0 + (size_t)c * 16 + lane) * 8 + h] = *(LAS const float*)(sl + SC_X + 64 + lane * 4);
              asm volatile("s_waitcnt lgkmcnt(0)" ::: "memory");
            }
#pragma unroll
            for (int t = 0; t < 16; ++t) {
                const float k = bf2f(kraw[t]), a = bf2f(araw[t]), r = bf2f(rraw[t]), ew = (float)eraw[t];
                const float kk = k * kkc * rsqrtf(fmaxf(*(LAS const float*)(sl + SC_X + t * 4), 1e-24f));
                const float kp = k * (1.f + (a - 1.f) * kac);
                const float at = -kk * W;
                W *= __expf(-ew);
                const float rt = r * W, iw = __builtin_amdgcn_rcpf(W);
                const unsigned wbk = pk_bf16(kk * a * iw, kp * iw), war = pk_bf16(at, rt);
                const bf16_t bh = (bf16_t)(wbk & 0xffffu), kh = (bf16_t)(wbk >> 16), ah = (bf16_t)(war & 0xffffu), rh = (bf16_t)(war >> 16);
                *(LAS bf16_t*)(sl + SC_AT + ((m * 16 + t) * 32 + pidx) * 2) = ah;
                *(LAS bf16_t*)(sl + SC_RT + ((m * 16 + t) * 32 + pidx) * 2) = rh;
                *(LAS bf16_t*)(sl + SC_BBT + (j * SC_BS + t) * 2) = bh;
                *(LAS bf16_t*)(sl + SC_KBT + (j * SC_BS + t) * 2) = kh;
                *(LAS bf16_t*)(sc + 0 + ((m * 16 + t) * 32 + pidx) * 2) = bh;
                *(LAS bf16_t*)(sc + 2048 + ((m * 16 + t) * 32 + pidx) * 2) = kh;
            }
            *(LAS float*)(sl + SC_WC + j * 4) = W;
#pragma unroll
            for (int q = 0; q < 4; ++q) *(LAS bf16_t*)(sl + SC_VP + (fr * 16 + 4 * fq + q) * 2) = vraw[q];
            if (cnext >= 0) pload(cnext);
            asm volatile("s_waitcnt lgkmcnt(0)" ::: "memory");
            f32x4 AB = (f32x4){0.f, 0.f, 0.f, 0.f}, AKm = AB, RBm = AB, RKm = AB;
#pragma unroll
            for (int kk2 = 0; kk2 < 2; ++kk2) {
                const int fo = ((kk2 * 16 + fr) * 32 + fq * 8) * 2;
                const bf16x8 fa = *(LAS const bf16x8*)(sl + SC_AT + fo), fr_ = *(LAS const bf16x8*)(sl + SC_RT + fo);
                const bf16x8 fb = *(LAS const bf16x8*)(sc + 0 + fo), fk = *(LAS const bf16x8*)(sc + 2048 + fo);
                AB = __builtin_amdgcn_mfma_f32_16x16x32_bf16(fa, fb, AB, 0, 0, 0); AKm = __builtin_amdgcn_mfma_f32_16x16x32_bf16(fa, fk, AKm, 0, 0, 0);
                RBm = __builtin_amdgcn_mfma_f32_16x16x32_bf16(fr_, fb, RBm, 0, 0, 0); RKm = __builtin_amdgcn_mfma_f32_16x16x32_bf16(fr_, fk, RKm, 0, 0, 0);
            }
#pragma unroll
            for (int r = 0; r < 4; ++r) { const int t = 4 * fq + r; const bool lo = fr < t, le = fr <= t;
                AB[r] = lo ? AB[r] : 0.f; AKm[r] = lo ? AKm[r] : 0.f; RBm[r] = le ? RBm[r] : 0.f; RKm[r] = le ? RKm[r] : 0.f; }
            asm volatile("s_waitcnt lgkmcnt(0)" ::: "memory");
            st_mat(sl + SC_AK, nullptr, nullptr, nullptr, AKm, fr, fq);
            st_mat(sl + SC_RB, nullptr, nullptr, nullptr, RBm, fr, fq);
            st_mat(sl + SC_RK, nullptr, nullptr, nullptr, RKm, fr, fq);
            LAS unsigned char* mL = sc, *mLT = sc + 512, *mIL = sc + 1024, *mL2 = sc + 1536, *mL2T = sc + 2048, *mIL2T = sc + 2560, *mL4 = sc + 3072, *mL4T = sc + 3584, *mIL4T = sc + 4096, *mIL8T = sc + 4608, *mP1 = sc + 5120, *mP2 = sc + 5632;
            st_mat(mL, mLT, nullptr, mIL, AB, fr, fq);
            const f32x4 L2 = mm16(mL, mLT, fr, fq);      st_mat(mL2, mL2T, mIL2T, nullptr, L2, fr, fq);
            const f32x4 L4 = mm16(mL2, mL2T, fr, fq);    const f32x4 P1 = mm16(mIL, mIL2T, fr, fq);
            st_mat(mL4, mL4T, mIL4T, nullptr, L4, fr, fq); st_mat(mP1, nullptr, nullptr, nullptr, P1, fr, fq);
            const f32x4 L8 = mm16(mL4, mL4T, fr, fq);    const f32x4 P2 = mm16(mP1, mIL4T, fr, fq);
            st_mat(nullptr, nullptr, mIL8T, nullptr, L8, fr, fq); st_mat(mP2, nullptr, nullptr, nullptr, P2, fr, fq);
            const f32x4 X = mm16(mP2, mIL8T, fr, fq);    st_mat(sl + SC_X, nullptr, nullptr, nullptr, X, fr, fq);
            asm volatile("s_waitcnt lgkmcnt(0)" ::: "memory");
        };
        f32x4 ST[4];
#pragma unroll
        for (int jt = 0; jt < 4; ++jt) ST[jt] = (f32x4){0.f, 0.f, 0.f, 0.f};
        auto consume = [&](int c, LAS const unsigned char* sl) {
            const bf16x8 s0 = __builtin_bit_cast(bf16x8, (u32x4){pk_bf16(ST[0][0], ST[0][1]), pk_bf16(ST[0][2], ST[0][3]), pk_bf16(ST[1][0], ST[1][1]), pk_bf16(ST[1][2], ST[1][3])});
            const bf16x8 s1 = __builtin_bit_cast(bf16x8, (u32x4){pk_bf16(ST[2][0], ST[2][1]), pk_bf16(ST[2][2], ST[2][3]), pk_bf16(ST[3][0], ST[3][1]), pk_bf16(ST[3][2], ST[3][3])});
            const bf16x8 at0 = *(LAS const bf16x8*)(sl + SC_AT + (fr * 32 + fq * 8) * 2), at1 = *(LAS const bf16x8*)(sl + SC_AT + ((16 + fr) * 32 + fq * 8) * 2);
            const bf16x8 rt0 = *(LAS const bf16x8*)(sl + SC_RT + (fr * 32 + fq * 8) * 2), rt1 = *(LAS const bf16x8*)(sl + SC_RT + ((16 + fr) * 32 + fq * 8) * 2);
            const int mo = (fr * 16 + 4 * fq) * 2;
            const bf16x8 vf = frag4(sl + SC_VP + mo), akf = frag4(sl + SC_AK + mo), xf = frag4(sl + SC_X + mo), rbf = frag4(sl + SC_RB + mo), rkf = frag4(sl + SC_RK + mo);
            const f32x4 z = (f32x4){0.f, 0.f, 0.f, 0.f};
            f32x4 g = __builtin_amdgcn_mfma_f32_16x16x32_bf16(at0, s0, z, 0, 0, 0);
            g = __builtin_amdgcn_mfma_f32_16x16x32_bf16(at1, s1, g, 0, 0, 0);
            g = __builtin_amdgcn_mfma_f32_16x16x32_bf16(akf, vf, g, 0, 0, 0);
            const f32x4 sa = __builtin_amdgcn_mfma_f32_16x16x32_bf16(xf, cfrag(g), z, 0, 0, 0);
            const bf16x8 saf = cfrag(sa);
            f32x4 y = __builtin_amdgcn_mfma_f32_16x16x32_bf16(rt0, s0, z, 0, 0, 0);
            y = __builtin_amdgcn_mfma_f32_16x16x32_bf16(rt1, s1, y, 0, 0, 0);
            y = __builtin_amdgcn_mfma_f32_16x16x32_bf16(rbf, saf, y, 0, 0, 0);
            y = __builtin_amdgcn_mfma_f32_16x16x32_bf16(rkf, vf, y, 0, 0, 0);
#pragma unroll
            for (int jt = 0; jt < 4; ++jt) {
                const f32x4 wc = *(LAS const f32x4*)(sl + SC_WC + (16 * jt + 4 * fq) * 4);
                const bf16x8 bb = frag4(sl + SC_BBT + ((16 * jt + fr) * SC_BS + 4 * fq) * 2), kb = frag4(sl + SC_KBT + ((16 * jt + fr) * SC_BS + 4 * fq) * 2);
                f32x4 acc = ST[jt];
                acc = __builtin_amdgcn_mfma_f32_16x16x32_bf16(bb, saf, acc, 0, 0, 0);
                acc = __builtin_amdgcn_mfma_f32_16x16x32_bf16(kb, vf, acc, 0, 0, 0);
                ST[jt] = acc * wc;
            }
#pragma unroll
            for (int r = 0; r < 4; ++r) Y[(tok0 + (size_t)c * 16 + 4 * fq + r) * 512 + h * 64 + rg * 16 + fr] = bf1(y[r]);
        };
        LAS unsigned char* scr = lds + SC_RING + (pw < 0 ? 0 : pw) * SC_SCR;
        if (wid >= 3) { pload(pw); pbuild(pw, lds + pw * SC_SLOT, scr, SC_NP + pw); }
        lds_barrier();
        for (int rd = 0; rd < NRD; ++rd) {
            if (wid == 0) {
#pragma unroll 1
                for (int q = 0; q < SC_NP; ++q) { const int c = rd * SC_NP + q; if (c < NCH) consume(c, lds + ((rd & 1) * SC_NP + q) * SC_SLOT); }
            } else if (wid >= 3) {
                const int cb = (rd + 1) * SC_NP + pw, cn = cb + SC_NP;
                if (cb < NCH) pbuild(cb, lds + (((rd + 1) & 1) * SC_NP + pw) * SC_SLOT, scr, cn < NCH ? cn : -1);
            }
            lds_barrier();
        }
        __syncthreads();
    }
}

__device__ __forceinline__ void phase_attn(const Params& p, int l, LAS unsigned char* ldsb) {
    unsigned char* R = p.ws + WS_R;
    const bf16_t* QKV = (const bf16_t*)(R + R_QKV); bf16_t* ATT = (bf16_t*)(R + R_ATT);
    const float* relb = p.in[7]; const float* sinks = p.in[8] + l * 8;
    const int tid = otid(), wid = tid >> 6, lane = tid & 63, fr = lane & 15, fq = lane >> 4;
    LAS bf16_t* Ks = (LAS bf16_t*)ldsb;
    LAS bf16_t* Vt = (LAS bf16_t*)(ldsb + 36864);
    LAS float* biasL = (LAS float*)(ldsb + 70656);
    LAS bf16_t* Pw = (LAS bf16_t*)(ldsb + 72704) + wid * (16 * 168);
    for (int item = obid(); item < 512; item += gridDim.x) {
        const int g = item & 1, n = (item >> 1) & 31, b = item >> 6;
        const long tokc = (long)b * SEQ + n * 128, tokp = tokc - 128;
        for (int idx = tid; idx < 2048; idx += 512) {
            const int key = idx >> 3, d8 = idx & 7; u32x4 v = (u32x4){0u, 0u, 0u, 0u}, kv = (u32x4){0u, 0u, 0u, 0u};
            if (n > 0 || key >= 128) { const bf16_t* src = QKV + (size_t)(tokp + key) * 768 + 512 + g * 64 + d8 * 8; kv = *(const u32x4*)src; v = *(const u32x4*)(src + 128); }
            *(LAS u32x4*)(Ks + key * 72 + d8 * 8) = kv;
#pragma unroll
            for (int e = 0; e < 8; ++e) Vt[(d8 * 8 + e) * 264 + key] = (bf16_t)((e & 1) ? (v[e >> 1] >> 16) : (v[e >> 1] & 0xffffu));
        }
        { const int hl = tid >> 7, d = tid & 127; int bk = d;
          if (d >= 16) { bk = 16 + (int)(__logf((float)d * 0.0625f) * (16.f / 2.07944154168f)); bk = bk > 31 ? 31 : bk; }
          biasL[tid] = relb[bk * 8 + g * 4 + hl]; }
        __syncthreads();
        const int hl = wid >> 1, hq = g * 4 + hl; const float sink = sinks[hq];
        for (int rt = 0; rt < 4; ++rt) {
            const int q0 = (wid & 1) * 64 + rt * 16, kstart = q0 < 96 ? q0 : 96;
            bf16x8 qa0, qa1; { const bf16_t* qp = QKV + (size_t)(tokc + q0 + fr) * 768 + hq * 64 + fq * 8; qa0 = *(const bf16x8*)qp; qa1 = *(const bf16x8*)(qp + 32); }
            f32x4 S[10];
#pragma unroll
            for (int kt = 0; kt < 10; ++kt) {
                LAS const bf16_t* kp = Ks + (kstart + kt * 16 + fr) * 72 + fq * 8;
                const bf16x8 k0 = *(LAS const bf16x8*)kp, k1 = *(LAS const bf16x8*)(kp + 32);
                f32x4 z = (f32x4){0.f, 0.f, 0.f, 0.f};
                z = __builtin_amdgcn_mfma_f32_16x16x32_bf16(qa0, k0, z, 0, 0, 0);
                z = __builtin_amdgcn_mfma_f32_16x16x32_bf16(qa1, k1, z, 0, 0, 0);
                S[kt] = z;
            }
            float mx[4] = {-INFINITY, -INFINITY, -INFINITY, -INFINITY};
#pragma unroll
            for (int kt = 0; kt < 10; ++kt)
#pragma unroll
                for (int j = 0; j < 4; ++j) {
                    const int key = kstart + kt * 16 + fr, dist = q0 + 4 * fq + j + 128 - key;
                    const bool ok = (dist >= 0) && (dist < 128) && (n > 0 || key >= 128);
                    const float s = ok ? (S[kt][j] * 0.125f + biasL[hl * 128 + (dist & 127)]) : -INFINITY;
                    S[kt][j] = s; mx[j] = fmaxf(mx[j], s);
                }
            float inv[4];
#pragma unroll
            for (int j = 0; j < 4; ++j) mx[j] = fmaxf(row16_max(mx[j]), sink);
            float sm[4] = {0.f, 0.f, 0.f, 0.f};
#pragma unroll
            for (int kt = 0; kt < 10; ++kt)
#pragma unroll
                for (int j = 0; j < 4; ++j) { const float e = __expf(S[kt][j] - mx[j]); S[kt][j] = e; sm[j] += e; }
#pragma unroll
            for (int j = 0; j < 4; ++j) inv[j] = 1.f / (row16_sum(sm[j]) + __expf(sink - mx[j]));
#pragma unroll
            for (int kt = 0; kt < 10; ++kt)
#pragma unroll
                for (int j = 0; j < 4; ++j) Pw[(4 * fq + j) * 168 + kt * 16 + fr] = (bf16_t)(pk_bf16(S[kt][j] * inv[j], 0.f) & 0xffffu);
            asm volatile("s_waitcnt lgkmcnt(0)" ::: "memory");
            __builtin_amdgcn_wave_barrier();
            f32x4 O[4];
#pragma unroll
            for (int dt = 0; dt < 4; ++dt) O[dt] = (f32x4){0.f, 0.f, 0.f, 0.f};
#pragma unroll
            for (int kk = 0; kk < 5; ++kk) {
                const bf16x8 pa = *(LAS const bf16x8*)(Pw + fr * 168 + kk * 32 + fq * 8);
#pragma unroll
                for (int dt = 0; dt < 4; ++dt) {
                    const bf16x8 vb = *(LAS const bf16x8*)(Vt + (dt * 16 + fr) * 264 + kstart + kk * 32 + fq * 8);
                    O[dt] = __builtin_amdgcn_mfma_f32_16x16x32_bf16(pa, vb, O[dt], 0, 0, 0);
                }
            }
#pragma unroll
            for (int dt = 0; dt < 4; ++dt)
#pragma unroll
                for (int j = 0; j < 4; ++j) ATT[(size_t)(tokc + q0 + 4 * fq + j) * 512 + hq * 64 + dt * 16 + fr] = (bf16_t)(pk_bf16(O[dt][j], 0.f) & 0xffffu);
            asm volatile("s_waitcnt lgkmcnt(0)" ::: "memory");
            __builtin_amdgcn_wave_barrier();
        }
        __syncthreads();
    }
}

__device__ __forceinline__ void phase_post(const Params& p, int l) {
    unsigned char* R = p.ws + WS_R;
    bf16_t* Y = (bf16_t*)(R + R_Y); const bf16_t* Vb = (const bf16_t*)(R + (l == 0 ? R_V : R_VNEW)); const bf16_t* G = (const bf16_t*)(R + R_G); const float* CB = (const float*)(R + R_CB);
    const float* gng = p.in[18] + (size_t)l * 512; const float* gnb = p.in[19] + (size_t)l * 512;
    const size_t total = (size_t)M_TOK * 64;
    for (size_t it = (size_t)obid() * 512 + otid(); it < total; it += (size_t)gridDim.x * 512) {
        const size_t row = it >> 6; const int c0 = (int)(it & 63) * 8, h = c0 >> 6;
        f32x4 y0, y1; unpack8(*(const u32x4*)(Y + row * 512 + c0), y0, y1);
        float s = y0[0] + y0[1] + y0[2] + y0[3] + y1[0] + y1[1] + y1[2] + y1[3];
        s += dpp_f<0xB1>(s); s += dpp_f<0x4E>(s); s += dpp_f<0x141>(s);
        const float mu = s * (1.f / 64.f);
        y0 -= mu; y1 -= mu;
        float q = y0[0] * y0[0] + y0[1] * y0[1] + y0[2] * y0[2] + y0[3] * y0[3] + y1[0] * y1[0] + y1[1] * y1[1] + y1[2] * y1[2] + y1[3] * y1[3];
        q += dpp_f<0xB1>(q); q += dpp_f<0x4E>(q); q += dpp_f<0x141>(q);
        const float rs = rsqrtf(q * (1.f / 64.f) + 64e-5f);
        f32x4 v0, v1, g0, g1; unpack8(*(const u32x4*)(Vb + row * 512 + c0), v0, v1); unpack8(*(const u32x4*)(G + row * 512 + c0), g0, g1);
        const float cb = CB[row * 8 + h];
        const f32x4 gg0 = *(const f32x4*)(gng + c0), gg1 = *(const f32x4*)(gng + c0 + 4), gb0 = *(const f32x4*)(gnb + c0), gb1 = *(const f32x4*)(gnb + c0 + 4);
        const f32x4 o0 = (y0 * rs * gg0 + gb0 + v0 * cb) * g0, o1 = (y1 * rs * gg1 + gb1 + v1 * cb) * g1;
        *(u32x4*)(Y + row * 512 + c0) = pack8(o0, o1);
    }
}


#define XB_TMO      128
#define XB_XCNT(j)  (256  + 64 * (j))
#define XB_XSUB(j)  (1280 + 64 * (j))
#define XB_XGEN(j)  (2304 + 64 * (j))
#define XB_TOP      3328
#define XB_TOPGEN   3392
#define XCD_BAR_WORDS 3456
#define XB_SPIN_CAP (1u << 20)
__device__ __forceinline__ unsigned xb_ld(unsigned* p)              { return __hip_atomic_load(p, __ATOMIC_RELAXED, __HIP_MEMORY_SCOPE_AGENT); }
__device__ __forceinline__ unsigned xb_add(unsigned* p, unsigned v) { return __hip_atomic_fetch_add(p, v, __ATOMIC_RELAXED, __HIP_MEMORY_SCOPE_AGENT); }
__device__ __forceinline__ unsigned xb_xcc_id() { return (unsigned)__builtin_amdgcn_s_getreg((3 << 11) | 20) & 0xFu; }
#define XB_SPIN(cond, bar) do { unsigned _sp = 0; while (cond) { __builtin_amdgcn_s_sleep(1); \
    if ((++_sp & 255u) == 0u) { if (xb_ld(&(bar)[XB_TMO])) break; if (_sp > XB_SPIN_CAP) { atomicAdd(&(bar)[XB_TMO], 1u); break; } } } } while (0)
struct XcdBarrier { unsigned* bar; unsigned x; volatile LAS unsigned* st; };
__device__ __forceinline__ XcdBarrier xcd_barrier_post(unsigned* bar, volatile LAS unsigned* st) {
    XcdBarrier b; b.bar = bar; b.x = xb_xcc_id(); b.st = st;
    if (threadIdx.x == 0) (void)xb_add(&bar[XB_XCNT(b.x)], 1u);
    return b;
}
__device__ __forceinline__ void xcd_barrier_complete(unsigned* bar, unsigned x, unsigned& nloc, unsigned& nx) {
    const unsigned G = gridDim.x * gridDim.y * gridDim.z;
    unsigned sum, cnt, mine, sp = 0u;
    for (;;) {
        sum = 0u; cnt = 0u; mine = 0u;
#pragma unroll
        for (unsigned j = 0; j < 16; ++j) { const unsigned c = xb_ld(&bar[XB_XCNT(j)]); sum += c; cnt += (c > 0u) ? 1u : 0u; mine = (j == x) ? c : mine; }
        if (sum == G) break;
        __builtin_amdgcn_s_sleep(1);
        if ((++sp & 255u) == 0u) { if (xb_ld(&bar[XB_TMO])) break; if (sp > XB_SPIN_CAP) { atomicAdd(&bar[XB_TMO], 1u); break; } }
    }
    nloc = mine > 0u ? mine : 1u; nx = cnt > 0u ? cnt : 1u;
}
__device__ __forceinline__ void xcd_barrier(const XcdBarrier& b) {
    asm volatile("s_waitcnt vmcnt(0)" ::: "memory");
    __syncthreads();
    if (threadIdx.x == 0) {
        unsigned* bar = b.bar;
        __builtin_amdgcn_s_waitcnt(0);
        unsigned nloc = b.st[0], nx = b.st[1];
        if (nloc == 0u) { xcd_barrier_complete(bar, b.x, nloc, nx); b.st[0] = nloc; b.st[1] = nx; }
        const unsigned old = xb_add(&bar[XB_XSUB(b.x)], 1u);
        const unsigned gen = old / nloc;
        if (old + 1u == (gen + 1u) * nloc) {
            __builtin_amdgcn_fence(__ATOMIC_RELEASE, "agent");
            asm volatile("s_waitcnt vmcnt(0)" ::: "memory");
            const unsigned og = xb_add(&bar[XB_TOP], 1u);
            const unsigned tg = og / nx;
            if (og + 1u == (tg + 1u) * nx) xb_add(&bar[XB_TOPGEN], 1u);
            else XB_SPIN(xb_ld(&bar[XB_TOPGEN]) == tg, bar);
            __builtin_amdgcn_fence(__ATOMIC_ACQUIRE, "agent");
            xb_add(&bar[XB_XGEN(b.x)], 1u);
            asm volatile("s_waitcnt vmcnt(0)" ::: "memory");
        } else {
            XB_SPIN(xb_ld(&bar[XB_XGEN(b.x)]) == gen, bar);
            __builtin_amdgcn_fence(__ATOMIC_ACQUIRE, "agent");
            asm volatile("s_waitcnt vmcnt(0)" ::: "memory");
        }
    }
    __syncthreads();
}

__device__ __forceinline__ void gsync(cg::grid_group& grid) {
    asm volatile("s_waitcnt vmcnt(0) lgkmcnt(0)" ::: "memory");
    grid.sync();
    __builtin_amdgcn_fence(__ATOMIC_ACQUIRE, "agent");
    asm volatile("s_waitcnt vmcnt(0)" ::: "memory");
}
__global__ void __launch_bounds__(512, 2) fwd_kernel(Params p) {
    extern __shared__ __attribute__((aligned(16))) unsigned char shm[];
    LAS unsigned char* lds = (LAS unsigned char*)shm;
    cg::grid_group grid = cg::this_grid();
    unsigned char* R = p.ws + WS_R;
    const bf16_t* WB = (const bf16_t*)(p.ws + WS_WB);
    bf16_t* XB = (bf16_t*)(p.ws + WS_XB);

    volatile LAS unsigned* xst = (volatile LAS unsigned*)(lds + LDS_XB);
    if (threadIdx.x == 0) { xst[0] = 0u; xst[1] = 0u; }
    __syncthreads();
    const XcdBarrier xb = xcd_barrier_post((unsigned*)(p.ws + WS_BAR), xst);
    phase_cvt_x(p);
    phase_wprep(p, 0, (LAS float*)lds);
    gsync(grid);
#pragma unroll 1
    for (int hs = 0; hs < 4; ++hs) {
        const int l = hs >> 1, j = hs & 1;
        { Gemm g; g.A = XB; g.Bt = WB + (j ? WB_GU1 : WB_GU0); g.M = M_TOK; g.N = 5632; g.K = 1024;
          EpiGU e; e.H = (bf16_t*)(R + R_HB); gemm_phase(lds, g, e); }
        xcd_barrier(xb);
        { Gemm g; g.A = (const bf16_t*)(R + R_HB); g.Bt = WB + (j ? WB_D1 : WB_D0); g.M = M_TOK; g.N = 1024; g.K = 2816;
          EpiP<FDelta> e; e.f.D = (bf16_t*)(R + R_DEL); e.f.beta = 0.5f; gemm_phase(lds, g, e); }
        xcd_barrier(xb);
        { const int li = l * 3 + (j ? 2 : 0); phase_ln((hs == 0) ? p.in[0] : p.out, (const bf16_t*)(R + R_DEL), p.out, XB, p.in[3] + (size_t)li * 1024, p.in[4] + (size_t)li * 1024, hs != 3); }
        if (hs == 1) phase_wprep(p, 1, (LAS float*)lds);
        xcd_barrier(xb);
        if (j == 0) {
            { Gemm g; g.A = XB; g.Bt = WB + WB_IN + (size_t)2048 * 1024; g.M = M_TOK; g.N = 2560; g.K = 1024;
              EpiP<FProj> e; e.f.QKV = (bf16_t*)(R + R_QKV); e.f.U = (bf16_t*)(R + R_U); e.f.bias = p.in[6] + (size_t)l * 4608 + 2048; gemm_phase(lds, g, e); }
            xcd_barrier(xb);
            phase_prep(p, l);
            xcd_barrier(xb);
            { Gemm g; g.A = (const bf16_t*)(R + R_AP); g.Bt = WB + WB_LR; g.M = M_TOK; g.N = 1536; g.K = 256;
              EpiP<FLowRank> e; e.f.EW = (_Float16*)(R + R_EW); e.f.A = (bf16_t*)(R + R_A); e.f.G = (bf16_t*)(R + R_G); e.f.w0 = p.in[10] + (size_t)l * 512; e.f.a0 = p.in[12] + (size_t)l * 512;
              gemm_phase(lds, g, e); }
            if (l >= 1) {
                Gemm g; g.A = (const bf16_t*)(R + R_V); g.Bt = WB + WB_V12; g.M = M_TOK; g.N = 512; g.K = 512;
                EpiP<FVmix> e; e.f.V = (const bf16_t*)(R + R_V); e.f.VF = (const bf16_t*)(p.ws + WS_VF); e.f.VN = (bf16_t*)(R + R_VNEW); e.f.v0p = p.in[20] + (size_t)(l - 1) * 512;
                gemm_phase(lds, g, e);
            }
            xcd_barrier(xb);
            phase_scan2(p, l, lds);
            phase_attn(p, l, lds);
            xcd_barrier(xb);
            phase_post(p, l);
            { Gemm g; g.A = XB; g.Bt = WB + WB_IN; g.M = M_TOK; g.N = 2048; g.K = 1024;
              EpiP<FGates> e; e.f.GA = (bf16_t*)(R + R_GA); e.f.GB = (bf16_t*)(R + R_GB); e.f.bias = p.in[6] + (size_t)l * 4608; gemm_phase(lds, g, e); }
            xcd_barrier(xb);
            { Gemm g; g.A = (const bf16_t*)(R + R_ATT); g.Bt = WB + WB_BA; g.M = M_TOK; g.N = 1024; g.K = 512;
              EpiP<FBranch<false>> e; e.f.GT = (const bf16_t*)(R + R_GA); e.f.MB = (bf16_t*)(R + R_MB); gemm_phase(lds, g, e); }
            asm volatile("s_waitcnt vmcnt(0)" ::: "memory");
            { Gemm g; g.A = (const bf16_t*)(R + R_Y); g.Bt = WB + WB_BB; g.M = M_TOK; g.N = 1024; g.K = 512;
              EpiP<FBranch<true>> e; e.f.GT = (const bf16_t*)(R + R_GB); e.f.MB = (bf16_t*)(R + R_MB); gemm_phase(lds, g, e); }
            xcd_barrier(xb);
            { Gemm g; g.A = (const bf16_t*)(R + R_MB); g.Bt = WB + WB_O; g.M = M_TOK; g.N = 1024; g.K = 1024;
              EpiP<FDelta> e; e.f.D = (bf16_t*)(R + R_DEL); e.f.beta = 1.0f; gemm_phase(lds, g, e); }
            xcd_barrier(xb);
            { const int li = l * 3 + 1; phase_ln(p.out, (const bf16_t*)(R + R_DEL), p.out, XB, p.in[3] + (size_t)li * 1024, p.in[4] + (size_t)li * 1024, true); }
            xcd_barrier(xb);
        }
    }
}

extern "C" void kernel_launch(void* const* d_in, const int* in_sizes, int n_in, void* d_out, int out_size, void* d_ws, size_t ws_size, hipStream_t stream) {
    static int grid = 0;
    if (grid == 0) {
        if (n_in != 26 || ws_size < WS_END) { grid = -1; return; }
        int dev = 0, cus = 0, per_cu = 0;
        (void)hipGetDevice(&dev);
        (void)hipDeviceGetAttribute(&cus, hipDeviceAttributeMultiprocessorCount, dev);
        (void)hipFuncSetAttribute((const void*)fwd_kernel, hipFuncAttributeMaxDynamicSharedMemorySize, LDS_BYTES);
        if (hipOccupancyMaxActiveBlocksPerMultiprocessor(&per_cu, (const void*)fwd_kernel, 512, LDS_BYTES) != hipSuccess || per_cu < 1) per_cu = 1;
        (void)hipGetLastError();
        grid = cus * 1;
        if (grid <= 0) grid = 256;
    }
    if (grid < 0) return;
    (void)hipMemsetAsync((unsigned char*)d_ws + WS_BAR, 0, XCD_BAR_WORDS * sizeof(unsigned), stream);
    Params p{};
    for (int i = 0; i < 26; ++i) p.in[i] = (const float*)d_in[i];
    p.out = (float*)d_out; p.ws = (unsigned char*)d_ws;
    void* args[] = {&p};
    (void)hipLaunchCooperativeKernel((const void*)fwd_kernel, dim3(grid), dim3(512), args, LDS_BYTES, stream);
}
```

```cpp
#include <hip/hip_runtime.h>
#include <hip/hip_cooperative_groups.h>
#include <math.h>
namespace cg = cooperative_groups;

#define LAS __attribute__((address_space(3)))
typedef unsigned short bf16_t;
typedef short bf16x8 __attribute__((ext_vector_type(8)));
typedef float f32x4 __attribute__((ext_vector_type(4)));
typedef unsigned u32x4 __attribute__((ext_vector_type(4)));
typedef unsigned u32x2 __attribute__((ext_vector_type(2)));

constexpr int M_TOK = 32768, SEQ = 4096;
constexpr float ALPHA = 1.41421356237f;
constexpr int LDS_XB = 153600;
constexpr int LDS_BYTES = LDS_XB + 16;

constexpr size_t MiB = 1u << 20;
constexpr size_t WS_WB = 0, WS_XB = 48 * MiB, WS_VF = 112 * MiB, WS_R = 144 * MiB, WS_END = 512 * MiB, WS_BAR = 47 * MiB + 512 * 1024;
constexpr size_t R_HB = 0, R_QKV = 0, R_U = 48 * MiB, R_VNEW = 48 * MiB, R_Y = 80 * MiB, R_ATT = 112 * MiB, R_CB = 144 * MiB,
                 R_R = 160 * MiB, R_K = 192 * MiB, R_V = 224 * MiB, R_AP = 256 * MiB, R_EW = 272 * MiB, R_A = 304 * MiB, R_G = 336 * MiB,
                 R_DEL = 176 * MiB, R_GA = 160 * MiB, R_GB = 256 * MiB, R_MB = 0;
constexpr size_t WB_GU0 = 0, WB_GU1 = 5767168, WB_D0 = 11534336, WB_D1 = 14417920, WB_IN = 17301504, WB_BA = 22020096, WB_BB = 22544384,
                 WB_O = 23068672, WB_LR = 24117248, WB_V12 = 24510464;

struct Params {
    const float* in[26];
    float* out;
    unsigned char* ws;
};

typedef __bf16 bf16x2_t __attribute__((ext_vector_type(2)));
typedef float f32x2_t __attribute__((ext_vector_type(2)));
__device__ __forceinline__ unsigned pk_bf16(float lo, float hi) { const f32x2_t f = {lo, hi}; return __builtin_bit_cast(unsigned, __builtin_convertvector(f, bf16x2_t)); }
__device__ __forceinline__ float bf_lo(unsigned w) { return __uint_as_float(w << 16); }
__device__ __forceinline__ float bf_hi(unsigned w) { return __uint_as_float(w & 0xffff0000u); }
__device__ __forceinline__ float bf2f(bf16_t b) { return __uint_as_float(((unsigned)b) << 16); }
__device__ __forceinline__ float sigm(float x) { return __builtin_amdgcn_rcpf(1.f + __expf(-x)); }
__device__ __forceinline__ int otid() { int t = threadIdx.x; asm volatile("" : "+v"(t)); return t; }
__device__ __forceinline__ int obid() { int b = blockIdx.x; asm volatile("" : "+s"(b)); return b; }
__device__ __forceinline__ float wave_sum(float x);
template <int CTRL> __device__ __forceinline__ float dpp_f(float x) { return __builtin_bit_cast(float, __builtin_amdgcn_mov_dpp(__builtin_bit_cast(int, x), CTRL, 0xF, 0xF, true)); }
__device__ __forceinline__ float row16_sum(float x) {
    x += dpp_f<0xB1>(x); x += dpp_f<0x4E>(x); x += dpp_f<0x141>(x); x += dpp_f<0x140>(x); return x;
}
__device__ __forceinline__ float row16_max(float x) {
    x = fmaxf(x, dpp_f<0xB1>(x)); x = fmaxf(x, dpp_f<0x4E>(x)); x = fmaxf(x, dpp_f<0x141>(x)); x = fmaxf(x, dpp_f<0x140>(x)); return x;
}
__device__ __forceinline__ float wave_sum(float x) {
    x = row16_sum(x);
    const int xi = __builtin_bit_cast(int, x);
    const float a = __builtin_bit_cast(float, __builtin_amdgcn_readlane(xi, 0)), b = __builtin_bit_cast(float, __builtin_amdgcn_readlane(xi, 16)),
                c = __builtin_bit_cast(float, __builtin_amdgcn_readlane(xi, 32)), d = __builtin_bit_cast(float, __builtin_amdgcn_readlane(xi, 48));
    return (a + b) + (c + d);
}

constexpr int BM = 256, BK = 64, HALF = 128, HTB = HALF * BK * 2, NXCD = 8, WGM = 8;
__device__ __forceinline__ int lds_byte(int r, int c) { const int st = (r >> 4) * 2 + (c >> 5), rr = r & 15, cc = c & 31, ob = rr * 64 + cc * 2; return st * 1024 + (ob ^ (((ob >> 9) & 1) << 5)); }
__device__ __forceinline__ void stage_rc(int b, int& R, int& C) { const int st = b / 1024, sb = b % 1024, swz = sb ^ (((sb >> 9) & 1) << 5); R = (st >> 1) * 16 + swz / 64; C = (st & 1) * 32 + (swz % 64) / 2; }
__device__ __forceinline__ int perm32(int rho) { const int n = rho >> 4, i = rho & 15; return 8 * (i >> 2) + 4 * n + (i & 3); }

struct Unit { int pm, pn; };
struct Gemm { const bf16_t* A; const bf16_t* Bt; int M, N, K; };
struct StaticOrder {
    int nM, nN, nwg, G, c;
    __device__ void init(int M, int N, int G_, int c_) { nM = M / BM; nN = N / BM; nwg = nM * nN; G = G_; c = c_; }
    __device__ bool next(int i, Unit& u) const {
        const long L = (long)i * G + c; if (L >= nwg) return false;
        int wgid = (int)L; { const int q = nwg / NXCD, r = nwg % NXCD, xcd = wgid % NXCD, off = wgid / NXCD; wgid = (xcd < r ? xcd * (q + 1) : r * (q + 1) + (xcd - r) * q) + off; }
        const int nig = WGM * nN, gid = wgid / nig, fm = gid * WGM, gsz = (nM - fm) < WGM ? (nM - fm) : WGM;
        u.pm = fm + ((wgid % nig) % gsz); u.pn = (wgid % nig) / gsz; return true;
    }
};

template <class Epi>
__device__ __forceinline__ void gemm_phase(LAS unsigned char* lds, const Gemm g, const Epi& E) {
    const int tid = otid(), wid = __builtin_amdgcn_readfirstlane(tid >> 6), lane = tid & 63, wr = wid >> 2, wc = wid & 3, fr = lane & 15, fq = lane >> 4;
    int Kop = g.K; asm volatile("" : "+s"(Kop));
    const int K = Kop, nt = K / BK;
    StaticOrder S; S.init(g.M, g.N, (int)gridDim.x, obid());
    unsigned voffA[2], voffB[2];
#pragma unroll
    for (int i = 0; i < 2; ++i) { int R, C; stage_rc(tid * 16 + i * 8192, R, C); const int Rb = Epi::PERM ? ((R & ~31) + perm32(R & 31)) : R;
        voffA[i] = (unsigned)(R * K + C) * 2u; voffB[i] = (unsigned)(Rb * K + C) * 2u; }
    const size_t kstep = (size_t)(BK * 2);
    const size_t hstep = (size_t)HALF * K * 2;
    const size_t tstep = 2 * hstep;
    const unsigned ldsw = (unsigned)wid * 1024u;
    const int aoff = lds_byte(wr * 64 + fr, fq * 8), boff = lds_byte(wc * 32 + fr, fq * 8);
#define PG8_SA(b, h) (((b) * 2 + (h)) * HTB)
#define PG8_SB(b, h) ((4 + (b) * 2 + (h)) * HTB)
#define PG8_STAGE(bufoff, gbase, voff) do { _Pragma("unroll") for (int _i = 0; _i < 2; ++_i) \
        __builtin_amdgcn_global_load_lds((const unsigned*)((const char*)(gbase) + (voff)[_i]), (LAS unsigned*)(lds + (bufoff) + ldsw + _i * 8192), 16, 0, 0); } while (0)
#define PG8_LDA(dst, b, h) do { _Pragma("unroll") for (int m = 0; m < 4; ++m) _Pragma("unroll") for (int k = 0; k < 2; ++k) dst[m][k] = *(const LAS bf16x8*)(lds + PG8_SA(b, h) + aoff + m * 2048 + k * 1024); } while (0)
#define PG8_LDB(dst, b, h) do { _Pragma("unroll") for (int n = 0; n < 2; ++n) _Pragma("unroll") for (int k = 0; k < 2; ++k) dst[n][k] = *(const LAS bf16x8*)(lds + PG8_SB(b, h) + boff + n * 2048 + k * 1024); } while (0)
#define PG8_MMA(ai, bj, At, Bt) do { __builtin_amdgcn_s_setprio(1); _Pragma("unroll") for (int m = 0; m < 4; ++m) _Pragma("unroll") for (int n = 0; n < 2; ++n) _Pragma("unroll") for (int k = 0; k < 2; ++k) \
        acc[ai][bj][m][n] = __builtin_amdgcn_mfma_f32_16x16x32_bf16(Bt[n][k], At[m][k], acc[ai][bj][m][n], 0, 0, 0); __builtin_amdgcn_s_setprio(0); } while (0)
#define PG8_WAIT_V(n) asm volatile("s_waitcnt vmcnt(" #n ")" ::: "memory")
#define PG8_WAIT_L(n) asm volatile("s_waitcnt lgkmcnt(" #n ")" ::: "memory")
#define PG8_BAR __builtin_amdgcn_s_barrier()
#define PG8_SCHED __builtin_amdgcn_sched_barrier(0)
    Unit cur, nxt; int ui = 0;
    if (!S.next(0, cur)) return;
    f32x4 acc[2][2][4][2];
#pragma unroll
    for (int a = 0; a < 2; ++a)
#pragma unroll
        for (int b = 0; b < 2; ++b)
#pragma unroll
            for (int m = 0; m < 4; ++m)
#pragma unroll
                for (int n = 0; n < 2; ++n) acc[a][b][m][n] = (f32x4){0.f, 0.f, 0.f, 0.f};
    bf16x8 At[4][2], B0[2][2], B1[2][2];
    const char* cA = (const char*)g.A + (size_t)cur.pm * tstep; const char* cB = (const char*)g.Bt + (size_t)cur.pn * tstep;
    PG8_STAGE(PG8_SB(0, 0), cB, voffB); PG8_STAGE(PG8_SA(0, 0), cA, voffA); PG8_STAGE(PG8_SB(0, 1), cB + hstep, voffB); PG8_STAGE(PG8_SA(0, 1), cA + hstep, voffA);
    if (wr == 1) PG8_BAR;
    PG8_WAIT_V(4); PG8_BAR;
    PG8_STAGE(PG8_SB(1, 0), cB + kstep, voffB); PG8_STAGE(PG8_SA(1, 0), cA + kstep, voffA); PG8_STAGE(PG8_SB(1, 1), cB + hstep + kstep, voffB);
    PG8_WAIT_V(6); PG8_BAR;
    for (;;) {
        const bool has_next = S.next(ui + 1, nxt);
        const char* nA = has_next ? (const char*)g.A + (size_t)nxt.pm * tstep : cA; const char* nB = has_next ? (const char*)g.Bt + (size_t)nxt.pn * tstep : cB;
#pragma unroll 1
        for (int t = 0; t < nt; t += 2) {
            const bool last = (t == nt - 2);
            const char* a1 = cA + (size_t)(t + 1) * kstep;
            const char* a2 = last ? nA : cA + (size_t)(t + 2) * kstep; const char* b2 = last ? nB : cB + (size_t)(t + 2) * kstep;
            const char* a3 = a2 + kstep; const char* b3 = b2 + kstep;
            PG8_LDB(B0, 0, 0); PG8_SCHED; PG8_LDA(At, 0, 0); PG8_STAGE(PG8_SA(1, 1), a1 + hstep, voffA);
            PG8_WAIT_L(8); PG8_BAR; PG8_WAIT_L(0); PG8_MMA(0, 0, At, B0); PG8_BAR; PG8_SCHED;
            PG8_LDB(B1, 0, 1); PG8_STAGE(PG8_SB(0, 0), b2, voffB);
            PG8_BAR; PG8_WAIT_L(0); PG8_MMA(0, 1, At, B1); PG8_BAR;
            PG8_LDA(At, 0, 1); PG8_STAGE(PG8_SA(0, 0), a2, voffA);
            PG8_BAR; PG8_WAIT_L(0); PG8_MMA(1, 0, At, B0); PG8_BAR; PG8_SCHED;
            PG8_STAGE(PG8_SB(0, 1), b2 + hstep, voffB);
            PG8_WAIT_V(6); PG8_BAR; PG8_MMA(1, 1, At, B1); PG8_BAR;
            PG8_LDB(B0, 1, 0); PG8_SCHED; PG8_LDA(At, 1, 0); PG8_STAGE(PG8_SA(0, 1), a2 + hstep, voffA);
            PG8_WAIT_L(8); PG8_BAR; PG8_WAIT_L(0); PG8_MMA(0, 0, At, B0); PG8_BAR; PG8_SCHED;
            PG8_LDB(B1, 1, 1); PG8_STAGE(PG8_SB(1, 0), b3, voffB);
            PG8_BAR; PG8_WAIT_L(0); PG8_MMA(0, 1, At, B1); PG8_BAR;
            PG8_LDA(At, 1, 1); PG8_STAGE(PG8_SA(1, 0), a3, voffA);
            PG8_BAR; PG8_WAIT_L(0); PG8_MMA(1, 0, At, B0); PG8_BAR; PG8_SCHED;
            PG8_STAGE(PG8_SB(1, 1), b3 + hstep, voffB);
            PG8_WAIT_V(6); PG8_BAR; PG8_MMA(1, 1, At, B1); PG8_BAR;
        }
        { int fr2 = fr, fq2 = fq; asm volatile("" : "+v"(fr2), "+v"(fq2)); E(acc, cur, wr, wc, fr2, fq2); }
        if (!has_next) break;
#pragma unroll
        for (int a = 0; a < 2; ++a)
#pragma unroll
            for (int b = 0; b < 2; ++b)
#pragma unroll
                for (int m = 0; m < 4; ++m)
#pragma unroll
                    for (int n = 0; n < 2; ++n) acc[a][b][m][n] = (f32x4){0.f, 0.f, 0.f, 0.f};
        cur = nxt; cA = nA; cB = nB; ++ui;
    }
    PG8_WAIT_V(0);
    if (wr == 0) PG8_BAR;
    PG8_BAR;
#undef PG8_SA
#undef PG8_SB
#undef PG8_STAGE
#undef PG8_LDA
#undef PG8_LDB
#undef PG8_MMA
#undef PG8_WAIT_V
#undef PG8_WAIT_L
#undef PG8_BAR
#undef PG8_SCHED
}

struct EpiGU {
    static constexpr bool PERM = false;
    bf16_t* H;
    __device__ __forceinline__ void operator()(const f32x4 (&acc)[2][2][4][2], const Unit& u, int wr, int wc, int fr, int fq) const {
        const int row0 = u.pm * BM + wr * 64 + fr, col0 = u.pn * 128 + wc * 32 + fq * 8;
#pragma unroll
        for (int ai = 0; ai < 2; ++ai)
#pragma unroll
            for (int m = 0; m < 4; ++m) {
                float h[8];
#pragma unroll
                for (int bj = 0; bj < 2; ++bj)
#pragma unroll
                    for (int j = 0; j < 4; ++j) { const float gt = acc[ai][bj][m][0][j], up = acc[ai][bj][m][1][j]; h[bj * 4 + j] = gt * sigm(gt) * up; }
                u32x4 w; w.x = pk_bf16(h[0], h[1]); w.y = pk_bf16(h[2], h[3]); w.z = pk_bf16(h[4], h[5]); w.w = pk_bf16(h[6], h[7]);
                *(u32x4*)(H + (size_t)(row0 + ai * HALF + m * 16) * 2816 + col0) = w;
            }
    }
};
struct EpiRes {
    static constexpr bool PERM = false;
    const float* res; float* out; float alpha, beta;
    __device__ __forceinline__ void operator()(const f32x4 (&acc)[2][2][4][2], const Unit& u, int wr, int wc, int fr, int fq) const {
        const int row0 = u.pm * BM + wr * 64 + fr, col0 = u.pn * BM + wc * 32 + 4 * fq;
#pragma unroll
        for (int ai = 0; ai < 2; ++ai)
#pragma unroll
            for (int mp = 0; mp < 2; ++mp) {
                f32x4 x[2][2][2];
#pragma unroll
                for (int mm = 0; mm < 2; ++mm)
#pragma unroll
                    for (int bj = 0; bj < 2; ++bj)
#pragma unroll
                        for (int n = 0; n < 2; ++n) x[mm][bj][n] = *(const f32x4*)(res + (size_t)(row0 + ai * HALF + (mp * 2 + mm) * 16) * 1024 + col0 + bj * HALF + n * 16);
#pragma unroll
                for (int mm = 0; mm < 2; ++mm)
#pragma unroll
                    for (int bj = 0; bj < 2; ++bj)
#pragma unroll
                        for (int n = 0; n < 2; ++n) *(f32x4*)(out + (size_t)(row0 + ai * HALF + (mp * 2 + mm) * 16) * 1024 + col0 + bj * HALF + n * 16) = x[mm][bj][n] * alpha + acc[ai][bj][mp * 2 + mm][n] * beta;
            }
    }
};
template <class F> struct EpiP {
    static constexpr bool PERM = true;
    F f;
    __device__ __forceinline__ void operator()(const f32x4 (&acc)[2][2][4][2], const Unit& u, int wr, int wc, int fr, int fq) const {
        const int row0 = u.pm * BM + wr * 64 + fr, cb0 = u.pn * BM + wc * 32 + 8 * fq;
        typename F::Col cv[2];
#pragma unroll
        for (int bj = 0; bj < 2; ++bj) cv[bj] = f.col(cb0 + bj * HALF, u.pn);
#pragma unroll
        for (int ai = 0; ai < 2; ++ai)
#pragma unroll
          for (int mp = 0; mp < 2; ++mp) {
            typename F::Pos pv[2][2];
#pragma unroll
            for (int mm = 0; mm < 2; ++mm)
#pragma unroll
                for (int bj = 0; bj < 2; ++bj) pv[mm][bj] = f.pos(row0 + ai * HALF + (mp * 2 + mm) * 16, cb0 + bj * HALF, u.pn);
#pragma unroll
            for (int mm = 0; mm < 2; ++mm)
#pragma unroll
                for (int bj = 0; bj < 2; ++bj) f.fin(row0 + ai * HALF + (mp * 2 + mm) * 16, cb0 + bj * HALF, acc[ai][bj][mp * 2 + mm][0], acc[ai][bj][mp * 2 + mm][1], u.pn, cv[bj], pv[mm][bj]);
          }
    }
};
struct Col8 { f32x4 a, b; };
struct None {};
__device__ __forceinline__ u32x4 pack8(const f32x4 a, const f32x4 b) { u32x4 w; w.x = pk_bf16(a[0], a[1]); w.y = pk_bf16(a[2], a[3]); w.z = pk_bf16(b[0], b[1]); w.w = pk_bf16(b[2], b[3]); return w; }
__device__ __forceinline__ void unpack8(const u32x4 w, f32x4& a, f32x4& b) { a[0] = bf_lo(w.x); a[1] = bf_hi(w.x); a[2] = bf_lo(w.y); a[3] = bf_hi(w.y); b[0] = bf_lo(w.z); b[1] = bf_hi(w.z); b[2] = bf_lo(w.w); b[3] = bf_hi(w.w); }
__device__ __forceinline__ f32x4 sigm4(const f32x4 x) { f32x4 r; r[0] = sigm(x[0]); r[1] = sigm(x[1]); r[2] = sigm(x[2]); r[3] = sigm(x[3]); return r; }

struct FProj {
    typedef Col8 Col; typedef None Pos;
    bf16_t* QKV; bf16_t* U; const float* bias;
    __device__ __forceinline__ Col col(int cb, int) const { Col c; c.a = *(const f32x4*)(bias + cb); c.b = *(const f32x4*)(bias + cb + 4); return c; }
    __device__ __forceinline__ Pos pos(int, int, int) const { return None{}; }
    __device__ __forceinline__ void fin(int row, int cb, f32x4 v0, f32x4 v1, int pn, const Col& c, const Pos&) const {
        bf16_t* dst = (pn < 3) ? (QKV + (size_t)row * 768 + cb) : (U + (size_t)row * 1792 + (cb - 768));
        *(u32x4*)dst = pack8(v0 + c.a, v1 + c.b);
    }
};
struct FLowRank {
    typedef Col8 Col; typedef None Pos;
    _Float16* EW; bf16_t* A; bf16_t* G; const float* w0; const float* a0;
    __device__ __forceinline__ Col col(int cb, int pn) const { Col c; const float* src = (pn < 2) ? (w0 + cb) : (a0 + ((cb - 512) & 511)); c.a = *(const f32x4*)src; c.b = *(const f32x4*)(src + 4); return c; }
    __device__ __forceinline__ Pos pos(int, int, int) const { return None{}; }
    __device__ __forceinline__ void fin(int row, int cb, f32x4 v0, f32x4 v1, int pn, const Col& c, const Pos&) const {
        if (pn < 2) {
            v0 = sigm4(v0 + c.a) * 0.60653065971f; v1 = sigm4(v1 + c.b) * 0.60653065971f;
            typedef _Float16 h8 __attribute__((ext_vector_type(8)));
            h8 o; o[0] = (_Float16)v0[0]; o[1] = (_Float16)v0[1]; o[2] = (_Float16)v0[2]; o[3] = (_Float16)v0[3]; o[4] = (_Float16)v1[0]; o[5] = (_Float16)v1[1]; o[6] = (_Float16)v1[2]; o[7] = (_Float16)v1[3];
            *(h8*)(EW + (size_t)row * 512 + cb) = o;
        } else if (pn < 4) {
            *(u32x4*)(A + (size_t)row * 512 + (cb - 512)) = pack8(sigm4(v0 + c.a), sigm4(v1 + c.b));
        } else {
            *(u32x4*)(G + (size_t)row * 512 + (cb - 1024)) = pack8(v0, v1);
        }
    }
};
struct FDelta {
    typedef None Col; typedef None Pos;
    bf16_t* D; float beta;
    __device__ __forceinline__ Col col(int, int) const { return None{}; }
    __device__ __forceinline__ Pos pos(int, int, int) const { return None{}; }
    __device__ __forceinline__ void fin(int row, int cb, f32x4 v0, f32x4 v1, int, const Col&, const Pos&) const {
        *(u32x4*)(D + (size_t)row * 1024 + cb) = pack8(v0 * beta, v1 * beta);
    }
};
struct Pos2 { u32x4 a, b; };
struct FVmix {
    typedef Col8 Col; typedef Pos2 Pos;
    const bf16_t* V; const bf16_t* VF; bf16_t* VN; const float* v0p;
    __device__ __forceinline__ Col col(int cb, int) const { Col c; c.a = *(const f32x4*)(v0p + cb); c.b = *(const f32x4*)(v0p + cb + 4); return c; }
    __device__ __forceinline__ Pos pos(int row, int cb, int) const { Pos q; q.a = *(const u32x4*)(V + (size_t)row * 512 + cb); q.b = *(const u32x4*)(VF + (size_t)row * 512 + cb); return q; }
    __device__ __forceinline__ void fin(int row, int cb, f32x4 v0, f32x4 v1, int, const Col& c, const Pos& q) const {
        const f32x4 s0 = sigm4(v0 + c.a), s1 = sigm4(v1 + c.b);
        f32x4 a0, a1, f0, f1; unpack8(q.a, a0, a1); unpack8(q.b, f0, f1);
        *(u32x4*)(VN + (size_t)row * 512 + cb) = pack8(a0 + (f0 - a0) * s0, a1 + (f1 - a1) * s1);
    }
};
struct FGates {
    typedef Col8 Col; typedef None Pos;
    bf16_t* GA; bf16_t* GB; const float* bias;
    __device__ __forceinline__ Col col(int cb, int) const { Col c; c.a = *(const f32x4*)(bias + cb); c.b = *(const f32x4*)(bias + cb + 4); return c; }
    __device__ __forceinline__ Pos pos(int, int, int) const { return None{}; }
    __device__ __forceinline__ void fin(int row, int cb, f32x4 v0, f32x4 v1, int pn, const Col& c, const Pos&) const {
        bf16_t* dst = (pn < 4) ? (GA + (size_t)row * 1024 + cb) : (GB + (size_t)row * 1024 + (cb - 1024));
        *(u32x4*)dst = pack8(sigm4(v0 + c.a), sigm4(v1 + c.b));
    }
};
template <bool ADD> struct FBranch {
    typedef None Col; typedef Pos2 Pos;
    const bf16_t* GT; bf16_t* MB;
    __device__ __forceinline__ Col col(int, int) const { return None{}; }
    __device__ __forceinline__ Pos pos(int row, int cb, int) const { Pos q; q.a = *(const u32x4*)(GT + (size_t)row * 1024 + cb); q.b = ADD ? *(const u32x4*)(MB + (size_t)row * 1024 + cb) : (u32x4){0u, 0u, 0u, 0u}; return q; }
    __device__ __forceinline__ void fin(int row, int cb, f32x4 v0, f32x4 v1, int, const Col&, const Pos& q) const {
        f32x4 g0, g1; unpack8(q.a, g0, g1);
        f32x4 r0 = g0 * v0, r1 = g1 * v1;
        if (ADD) { f32x4 m0, m1; unpack8(q.b, m0, m1); r0 += m0; r1 += m1; }
        *(u32x4*)(MB + (size_t)row * 1024 + cb) = pack8(r0, r1);
    }
};

__device__ __forceinline__ int gu_row(int c) {
    const int nn = c >= 2816 ? 1 : 0, hc = c - 2816 * nn, pn = hc >> 7, rem = hc & 127, wc = rem >> 5, r5 = rem & 31, ih = r5 >> 3, bj = (r5 >> 2) & 1, il = r5 & 3;
    return 256 * pn + bj * 128 + wc * 32 + nn * 16 + ih * 4 + il;
}
__device__ __forceinline__ void wtrans(const float* __restrict__ src, int K, int N, bf16_t* __restrict__ dst, int ldd, int mode, LAS float* tile) {
    const int tid = otid(), tn = N >> 6, nt = (K >> 6) * tn;
    for (int t = obid(); t < nt; t += gridDim.x) {
        const int k0 = (t / tn) << 6, c0 = (t % tn) << 6;
        {
#pragma unroll
          for (int i = 0; i < 2; ++i) { const int e = tid + 512 * i, kl = e >> 4, c4 = (e & 15) * 4;
              const f32x4 v4 = *(const f32x4*)(src + (size_t)(k0 + kl) * N + c0 + c4);
              tile[kl * 65 + c4] = v4[0]; tile[kl * 65 + c4 + 1] = v4[1]; tile[kl * 65 + c4 + 2] = v4[2]; tile[kl * 65 + c4 + 3] = v4[3]; } }
        __syncthreads();
        { const int kp = tid & 31, cl0 = tid >> 5;
#pragma unroll
          for (int i = 0; i < 4; ++i) { const int cl = cl0 + 16 * i, c = c0 + cl; const int R = mode ? gu_row(c) : c;
              *(unsigned*)(dst + (size_t)R * ldd + k0 + 2 * kp) = pk_bf16(tile[(2 * kp) * 65 + cl], tile[(2 * kp + 1) * 65 + cl]); } }
        __syncthreads();
    }
}
__device__ __forceinline__ void phase_wprep(const Params& p, int l, LAS float* tile) {
    bf16_t* WB = (bf16_t*)(p.ws + WS_WB);
    wtrans(p.in[1] + (size_t)(l * 2 + 0) * 1024 * 5632, 1024, 5632, WB + WB_GU0, 1024, 1, tile);
    wtrans(p.in[1] + (size_t)(l * 2 + 1) * 1024 * 5632, 1024, 5632, WB + WB_GU1, 1024, 1, tile);
    wtrans(p.in[2] + (size_t)(l * 2 + 0) * 2816 * 1024, 2816, 1024, WB + WB_D0, 2816, 0, tile);
    wtrans(p.in[2] + (size_t)(l * 2 + 1) * 2816 * 1024, 2816, 1024, WB + WB_D1, 2816, 0, tile);
    wtrans(p.in[5] + (size_t)l * 1024 * 4608, 1024, 4608, WB + WB_IN, 1024, 0, tile);
    wtrans(p.in[23] + (size_t)l * 512 * 1024, 512, 1024, WB + WB_BA, 512, 0, tile);
    wtrans(p.in[24] + (size_t)l * 512 * 1024, 512, 1024, WB + WB_BB, 512, 0, tile);
    wtrans(p.in[25] + (size_t)l * 1024 * 1024, 1024, 1024, WB + WB_O, 1024, 0, tile);
    const int gt = obid() * 512 + otid(), nth = gridDim.x * 512;
    {
        const float* w2 = p.in[11] + (size_t)l * 64 * 512; const float* a2 = p.in[13] + (size_t)l * 64 * 512; const float* g2 = p.in[14] + (size_t)l * 128 * 512;
        for (int idx = gt; idx < 1536 * 256; idx += nth) { const int n = idx >> 8, k = idx & 255; float v = 0.f;
            if (n < 512) { if (k < 64) v = w2[k * 512 + n]; }
            else if (n < 1024) { if (k >= 64 && k < 128) v = a2[(k - 64) * 512 + (n - 512)]; }
            else { if (k >= 128) v = g2[(k - 128) * 512 + (n - 1024)]; }
            WB[WB_LR + idx] = (bf16_t)(pk_bf16(v, 0.f) & 0xffffu); }
    }
    if (l >= 1) {
        const float* v1 = p.in[21] + (size_t)(l - 1) * 512 * 32; const float* v2 = p.in[22] + (size_t)(l - 1) * 32 * 512;
        for (int idx = gt; idx < 512 * 512; idx += nth) { const int n = idx >> 9, k = idx & 511; float s = 0.f;
#pragma unroll 8
            for (int r = 0; r < 32; ++r) s += v1[k * 32 + r] * v2[r * 512 + n];
            WB[WB_V12 + idx] = (bf16_t)(pk_bf16(s, 0.f) & 0xffffu); }
    }
}
__device__ __forceinline__ void phase_cvt_x(const Params& p) {
    const float* x = p.in[0]; bf16_t* XB = (bf16_t*)(p.ws + WS_XB);
    const size_t n8 = (size_t)M_TOK * 1024 / 8, nth = (size_t)gridDim.x * 512;
    for (size_t i = (size_t)obid() * 512 + otid(); i < n8; i += 2 * nth) {
        const size_t i2 = i + nth; const bool h2 = i2 < n8;
        const f32x4 a = *(const f32x4*)(x + i * 8), b = *(const f32x4*)(x + i * 8 + 4);
        f32x4 c = a, d = b; if (h2) { c = *(const f32x4*)(x + i2 * 8); d = *(const f32x4*)(x + i2 * 8 + 4); }
        *(u32x4*)(XB + i * 8) = pack8(a, b);
        if (h2) *(u32x4*)(XB + i2 * 8) = pack8(c, d);
    }
}

__device__ __forceinline__ void phase_ln(const float* RES, const bf16_t* DEL, float* X, bf16_t* XB, const float* g, const float* b, bool write_xb) {
    const int tid = otid(), wid = tid >> 6, lane = tid & 63;
    const int nw = gridDim.x * 8, w0 = obid() * 8 + wid;
    for (int base = w0; base < M_TOK; base += nw * 4) {
        f32x4 v[4][4];
#pragma unroll
        for (int r = 0; r < 4; ++r) { const float* xr = RES + (size_t)(base + r * nw) * 1024; const bf16_t* dr = DEL + (size_t)(base + r * nw) * 1024;
#pragma unroll
            for (int i = 0; i < 2; ++i) { const int c = i * 512 + lane * 8; const f32x4 xa = *(const f32x4*)(xr + c), xb2 = *(const f32x4*)(xr + c + 4); const u32x4 d4 = *(const u32x4*)(dr + c);
                f32x4 da, db; unpack8(d4, da, db); v[r][2 * i] = xa * ALPHA + da; v[r][2 * i + 1] = xb2 * ALPHA + db; } }
        float mean[4], rs[4];
#pragma unroll
        for (int r = 0; r < 4; ++r) { float s = 0.f;
#pragma unroll
            for (int i = 0; i < 4; ++i) s += v[r][i][0] + v[r][i][1] + v[r][i][2] + v[r][i][3];
            mean[r] = wave_sum(s) * (1.f / 1024.f); }
#pragma unroll
        for (int r = 0; r < 4; ++r) { float q = 0.f;
#pragma unroll
            for (int i = 0; i < 4; ++i) { v[r][i] -= mean[r]; q += v[r][i][0] * v[r][i][0] + v[r][i][1] * v[r][i][1] + v[r][i][2] * v[r][i][2] + v[r][i][3] * v[r][i][3]; }
            rs[r] = rsqrtf(wave_sum(q) * (1.f / 1024.f) + 1e-5f); }
#pragma unroll
        for (int i = 0; i < 2; ++i) { const int c = i * 512 + lane * 8;
            const f32x4 ga = *(const f32x4*)(g + c), gb = *(const f32x4*)(g + c + 4), ba = *(const f32x4*)(b + c), bb = *(const f32x4*)(b + c + 4);
#pragma unroll
            for (int r = 0; r < 4; ++r) { const size_t ro = (size_t)(base + r * nw) * 1024 + c;
                const f32x4 oa = v[r][2 * i] * rs[r] * ga + ba, ob = v[r][2 * i + 1] * rs[r] * gb + bb;
                *(f32x4*)(X + ro) = oa; *(f32x4*)(X + ro + 4) = ob;
                if (write_xb) *(u32x4*)(XB + ro) = pack8(oa, ob); } }
    }
}

__device__ __forceinline__ void phase_prep(const Params& p, int l) {
    unsigned char* R = p.ws + WS_R;
    const bf16_t* U = (const bf16_t*)(R + R_U); bf16_t* Rb = (bf16_t*)(R + R_R); bf16_t* Kb = (bf16_t*)(R + R_K); bf16_t* Vb = (bf16_t*)(R + R_V); bf16_t* AP = (bf16_t*)(R + R_AP);
    bf16_t* VF = (bf16_t*)(p.ws + WS_VF);
    const float* mu = p.in[9] + (size_t)l * 1792;
    const int tid = otid(), wid = tid >> 6, lane = tid & 63;
    const bool has3 = lane < 32;
    f32x4 m0[4], m1[4];
#pragma unroll
    for (int i = 0; i < 4; ++i) { const int c = (i < 3 || has3) ? (lane + 64 * i) * 8 : 0; m0[i] = *(const f32x4*)(mu + c); m1[i] = *(const f32x4*)(mu + c + 4); }
    for (int wv = obid() * 8 + wid; wv < M_TOK / 16; wv += gridDim.x * 8) {
        const int row0 = wv * 16;
        u32x4 prv[4], cur[4];
#pragma unroll
        for (int i = 0; i < 4; ++i) { prv[i] = (u32x4){0u, 0u, 0u, 0u}; cur[i] = prv[i]; }
        if ((row0 & (SEQ - 1)) != 0) {
#pragma unroll
            for (int i = 0; i < 4; ++i) if (i < 3 || has3) prv[i] = *(const u32x4*)(U + (size_t)(row0 - 1) * 1792 + (lane + 64 * i) * 8);
        }
#pragma unroll
        for (int i = 0; i < 4; ++i) if (i < 3 || has3) cur[i] = *(const u32x4*)(U + (size_t)row0 * 1792 + (lane + 64 * i) * 8);
#pragma unroll 2
        for (int r = 0; r < 16; ++r) {
            const int row = row0 + r;
            u32x4 nxt[4];
#pragma unroll
            for (int i = 0; i < 4; ++i) { nxt[i] = (u32x4){0u, 0u, 0u, 0u}; if (r < 15 && (i < 3 || has3)) nxt[i] = *(const u32x4*)(U + (size_t)(row + 1) * 1792 + (lane + 64 * i) * 8); }
#pragma unroll
            for (int i = 0; i < 4; ++i) {
                f32x4 c0v, c1v, p0v, p1v; unpack8(cur[i], c0v, c1v); unpack8(prv[i], p0v, p1v);
                f32x4 u0 = c0v + (p0v - c0v) * m0[i], u1 = c1v + (p1v - c1v) * m1[i];
                if (i == 0) *(u32x4*)(Rb + (size_t)row * 512 + lane * 8) = pack8(u0, u1);
                else if (i == 1) *(u32x4*)(Kb + (size_t)row * 512 + lane * 8) = pack8(u0, u1);
                else if (i == 2) { const u32x4 w = pack8(u0, u1); *(u32x4*)(Vb + (size_t)row * 512 + lane * 8) = w; if (l == 0) *(u32x4*)(VF + (size_t)row * 512 + lane * 8) = w; }
                else if (has3) {
                    if (lane < 8) {
#pragma unroll
                        for (int j = 0; j < 4; ++j) { u0[j] = 1.f - 2.f * __builtin_amdgcn_rcpf(__expf(2.f * u0[j]) + 1.f); u1[j] = 1.f - 2.f * __builtin_amdgcn_rcpf(__expf(2.f * u1[j]) + 1.f); }
                    } else if (lane >= 16) { u0 = sigm4(u0); u1 = sigm4(u1); }
                    *(u32x4*)(AP + (size_t)row * 256 + lane * 8) = pack8(u0, u1);
                }
            }
#pragma unroll
            for (int i = 0; i < 4; ++i) { prv[i] = cur[i]; cur[i] = nxt[i]; }
        }
    }
}

__device__ __forceinline__ void lds_barrier() { asm volatile("s_waitcnt lgkmcnt(0)" ::: "memory"); __builtin_amdgcn_s_barrier(); asm volatile("" ::: "memory"); }
constexpr int SC_SLOT = 12288, SC_AT = 0, SC_RT = 2048, SC_BBT = 4096, SC_KBT = 6656, SC_AK = 9216, SC_X = 9728, SC_RB = 10240, SC_RK = 10752, SC_VP = 11264, SC_WC = 11776;
constexpr int SC_BS = 20;
constexpr int SC_NP = 5, SC_RING = 2 * SC_NP * SC_SLOT, SC_SCR = 6144;
__device__ __forceinline__ bf16x8 frag4(LAS const unsigned char* p) { const u32x2 w = *(LAS const u32x2*)p; return __builtin_bit_cast(bf16x8, (u32x4){w.x, w.y, 0u, 0u}); }
__device__ __forceinline__ bf16x8 cfrag(const f32x4 c) { return __builtin_bit_cast(bf16x8, (u32x4){pk_bf16(c[0], c[1]), pk_bf16(c[2], c[3]), 0u, 0u}); }
__device__ __forceinline__ bf16_t bf1(float x) { return (bf16_t)(pk_bf16(x, 0.f) & 0xffffu); }
__device__ __forceinline__ float wave_sum64(float x) { x = row16_sum(x); x += __shfl_xor(x, 16); x += __shfl_xor(x, 32); return x; }
__device__ __forceinline__ void st_mat(LAS unsigned char* rm, LAS unsigned char* tr, LAS unsigned char* trI, LAS unsigned char* rmI, const f32x4 c, int fr, int fq) {
#pragma unroll
    for (int r = 0; r < 4; ++r) { const int t = 4 * fq + r; const float v = c[r], vi = v + (t == fr ? 1.f : 0.f);
        if (rm) *(LAS bf16_t*)(rm + (t * 16 + fr) * 2) = bf1(v);
        if (tr) *(LAS bf16_t*)(tr + (fr * 16 + t) * 2) = bf1(v);
        if (trI) *(LAS bf16_t*)(trI + (fr * 16 + t) * 2) = bf1(vi);
        if (rmI) *(LAS bf16_t*)(rmI + (t * 16 + fr) * 2) = bf1(vi); }
}
__device__ __forceinline__ f32x4 mm16(LAS const unsigned char* Arm, LAS const unsigned char* Btr, int fr, int fq) {
    asm volatile("s_waitcnt lgkmcnt(0)" ::: "memory");
    const bf16x8 a = frag4(Arm + (fr * 16 + 4 * fq) * 2), b = frag4(Btr + (fr * 16 + 4 * fq) * 2);
    return __builtin_amdgcn_mfma_f32_16x16x32_bf16(a, b, (f32x4){0.f, 0.f, 0.f, 0.f}, 0, 0, 0);
}
__device__ __forceinline__ void phase_scan2(const Params& p, int l, LAS unsigned char* lds) {
    unsigned char* R = p.ws + WS_R;
    const bf16_t* Rb = (const bf16_t*)(R + R_R); const bf16_t* Kb = (const bf16_t*)(R + R_K); const bf16_t* Vb = (const bf16_t*)(R + (l == 0 ? R_V : R_VNEW));
    const bf16_t* Ab = (const bf16_t*)(R + R_A); const _Float16* EW = (const _Float16*)(R + R_EW);
    bf16_t* Y = (bf16_t*)(R + R_Y); float* CB = (float*)(R + R_CB);
    const float* k_k = p.in[15] + (size_t)l * 512; const float* k_a = p.in[16] + (size_t)l * 512; const float* r_k = p.in[17] + (size_t)l * 512;
    const int tid = otid(), wid = tid >> 6, lane = tid & 63, fr = lane & 15, fq = lane >> 4;
    constexpr int NCH = SEQ / 16, NRD = (NCH + SC_NP - 1) / SC_NP;
    for (int job = obid(); job < 256; job += gridDim.x) {
        const int bh = job >> 2, rg = job & 3, b = bh >> 3, h = bh & 7;
        const size_t tok0 = (size_t)b * SEQ;
        const int pw = wid - 3, j = lane;
        const float kkc = k_k[h * 64 + j], kac = k_a[h * 64 + j], rkc = r_k[h * 64 + j];
        unsigned short kraw[16], araw[16], rraw[16]; _Float16 eraw[16]; unsigned short vraw[4];
#pragma unroll
        for (int t = 0; t < 16; ++t) { kraw[t] = 0; araw[t] = 0; rraw[t] = 0; eraw[t] = (_Float16)0; }
#pragma unroll
        for (int q = 0; q < 4; ++q) vraw[q] = 0;
        auto pload = [&](int c) {
            const size_t base = (tok0 + (size_t)c * 16) * 512 + h * 64;
#pragma unroll
            for (int t = 0; t < 16; ++t) { const size_t off = base + (size_t)t * 512 + j; kraw[t] = Kb[off]; araw[t] = Ab[off]; rraw[t] = Rb[off]; eraw[t] = EW[off]; }
#pragma unroll
            for (int q = 0; q < 4; ++q) vraw[q] = Vb[base + (size_t)(4 * fq + q) * 512 + rg * 16 + fr];
        };
        auto pbuild = [&](int c, LAS unsigned char* sl, LAS unsigned char* sc, int cnext) {
            float W = 1.f;
            const int m = j >> 5, tp = (j >> 4) & 1, jw = j & 15, pidx = (jw >> 2) * 8 + tp * 4 + (jw & 3);
#pragma unroll
            for (int t = 0; t < 16; ++t) {
                const float k = bf2f(kraw[t]), a = bf2f(araw[t]), r = bf2f(rraw[t]);
                const float q = k * kkc, kp1 = k * (1.f + (a - 1.f) * kac);
                *(LAS bf16_t*)(sc + 0 + (t * 64 + j) * 2) = bf1(q * q);
                *(LAS bf16_t*)(sc + 2048 + (t * 64 + j) * 2) = bf1(r * kp1 * rkc);
            }
            asm volatile("s_waitcnt lgkmcnt(0)" ::: "memory");
            { const bf16x8 ones = __builtin_bit_cast(bf16x8, (u32x4){0x3F803F80u, 0x3F803F80u, 0x3F803F80u, 0x3F803F80u});
              f32x4 sq = (f32x4){0.f, 0.f, 0.f, 0.f}, sb = sq;
#pragma unroll
              for (int kk2 = 0; kk2 < 2; ++kk2) {
                  const bf16x8 fa = *(LAS const bf16x8*)(sc + 0 + (fr * 64 + kk2 * 32 + fq * 8) * 2), fu = *(LAS const bf16x8*)(sc + 2048 + (fr * 64 + kk2 * 32 + fq * 8) * 2);
                  sq = __builtin_amdgcn_mfma_f32_16x16x32_bf16(fa, ones, sq, 0, 0, 0); sb = __builtin_amdgcn_mfma_f32_16x16x32_bf16(fu, ones, sb, 0, 0, 0);
              }
              if (fr == 0) { *(LAS f32x4*)(sl + SC_X + fq * 16) = sq; *(LAS f32x4*)(sl + SC_X + 64 + fq * 16) = sb; }
              asm volatile("s_waitcnt lgkmcnt(0)" ::: "memory");
              if (rg == 0 && lane < 16) CB[(tok0 + (size_t)c * 16 + lane) * 8 + h] = *(LAS const float*)(sl + SC_X + 64 + lane * 4);
              asm volatile("s_waitcnt lgkmcnt(0)" ::: "memory");
            }
#pragma unroll
            for (int t = 0; t < 16; ++t) {
                const float k = bf2f(kraw[t]), a = bf2f(araw[t]), r = bf2f(rraw[t]), ew = (float)eraw[t];
                const float kk = k * kkc * rsqrtf(fmaxf(*(LAS const float*)(sl + SC_X + t * 4), 1e-24f));
                const float kp = k * (1.f + (a - 1.f) * kac);
                const float at = -kk * W;
                W *= __expf(-ew);
                const float rt = r * W, iw = __builtin_amdgcn_rcpf(W);
                const unsigned wbk = pk_bf16(kk * a * iw, kp * iw), war = pk_bf16(at, rt);
                const bf16_t bh = (bf16_t)(wbk & 0xffffu), kh = (bf16_t)(wbk >> 16), ah = (bf16_t)(war & 0xffffu), rh = (bf16_t)(war >> 16);
                *(LAS bf16_t*)(sl + SC_AT + ((m * 16 + t) * 32 + pidx) * 2) = ah;
                *(LAS bf16_t*)(sl + SC_RT + ((m * 16 + t) * 32 + pidx) * 2) = rh;
                *(LAS bf16_t*)(sl + SC_BBT + (j * SC_BS + t) * 2) = bh;
                *(LAS bf16_t*)(sl + SC_KBT + (j * SC_BS + t) * 2) = kh;
                *(LAS bf16_t*)(sc + 0 + ((m * 16 + t) * 32 + pidx) * 2) = bh;
                *(LAS bf16_t*)(sc + 2048 + ((m * 16 + t) * 32 + pidx) * 2) = kh;
            }
            *(LAS float*)(sl + SC_WC + j * 4) = W;
#pragma unroll
            for (int q = 0; q < 4; ++q) *(LAS bf16_t*)(sl + SC_VP + (fr * 16 + 4 * fq + q) * 2) = vraw[q];
            if (cnext >= 0) pload(cnext);
            asm volatile("s_waitcnt lgkmcnt(0)" ::: "memory");
            f32x4 AB = (f32x4){0.f, 0.f, 0.f, 0.f}, AKm = AB, RBm = AB, RKm = AB;
#pragma unroll
            for (int kk2 = 0; kk2 < 2; ++kk2) {
                const int fo = ((kk2 * 16 + fr) * 32 + fq * 8) * 2;
                const bf16x8 fa = *(LAS const bf16x8*)(sl + SC_AT + fo), fr_ = *(LAS const bf16x8*)(sl + SC_RT + fo);
                const bf16x8 fb = *(LAS const bf16x8*)(sc + 0 + fo), fk = *(LAS const bf16x8*)(sc + 2048 + fo);
                AB = __builtin_amdgcn_mfma_f32_16x16x32_bf16(fa, fb, AB, 0, 0, 0); AKm = __builtin_amdgcn_mfma_f32_16x16x32_bf16(fa, fk, AKm, 0, 0, 0);
                RBm = __builtin_amdgcn_mfma_f32_16x16x32_bf16(fr_, fb, RBm, 0, 0, 0); RKm = __builtin_amdgcn_mfma_f32_16x16x32_bf16(fr_, fk, RKm, 0, 0, 0);
            }
#pragma unroll
            for (int r = 0; r < 4; ++r) { const int t = 4 * fq + r; const bool lo = fr < t, le = fr <= t;
                AB[r] = lo ? AB[r] : 0.f; AKm[r] = lo ? AKm[r] : 0.f; RBm[r] = le ? RBm[r] : 0.f; RKm[r] = le ? RKm[r] : 0.f; }
            asm volatile("s_waitcnt lgkmcnt(0)" ::: "memory");
            st_mat(sl + SC_AK, nullptr, nullptr, nullptr, AKm, fr, fq);
            st_mat(sl + SC_RB, nullptr, nullptr, nullptr, RBm, fr, fq);
            st_mat(sl + SC_RK, nullptr, nullptr, nullptr, RKm, fr, fq);
            LAS unsigned char* mL = sc, *mLT = sc + 512, *mIL = sc + 1024, *mL2 = sc + 1536, *mL2T = sc + 2048, *mIL2T = sc + 2560, *mL4 = sc + 3072, *mL4T = sc + 3584, *mIL4T = sc + 4096, *mIL8T = sc + 4608, *mP1 = sc + 5120, *mP2 = sc + 5632;
            st_mat(mL, mLT, nullptr, mIL, AB, fr, fq);
            const f32x4 L2 = mm16(mL, mLT, fr, fq);      st_mat(mL2, mL2T, mIL2T, nullptr, L2, fr, fq);
            const f32x4 L4 = mm16(mL2, mL2T, fr, fq);    const f32x4 P1 = mm16(mIL, mIL2T, fr, fq);
            st_mat(mL4, mL4T, mIL4T, nullptr, L4, fr, fq); st_mat(mP1, nullptr, nullptr, nullptr, P1, fr, fq);
            const f32x4 L8 = mm16(mL4, mL4T, fr, fq);    const f32x4 P2 = mm16(mP1, mIL4T, fr, fq);
            st_mat(nullptr, nullptr, mIL8T, nullptr, L8, fr, fq); st_mat(mP2, nullptr, nullptr, nullptr, P2, fr, fq);
            const f32x4 X = mm16(mP2, mIL8T, fr, fq);    st_mat(sl + SC_X, nullptr, nullptr, nullptr, X, fr, fq);
            asm volatile("s_waitcnt lgkmcnt(0)" ::: "memory");
        };
        f32x4 ST[4];
#pragma unroll
        for (int jt = 0; jt < 4; ++jt) ST[jt] = (f32x4){0.f, 0.f, 0.f, 0.f};
        auto consume = [&](int c, LAS const unsigned char* sl) {
            const bf16x8 s0 = __builtin_bit_cast(bf16x8, (u32x4){pk_bf16(ST[0][0], ST[0][1]), pk_bf16(ST[0][2], ST[0][3]), pk_bf16(ST[1][0], ST[1][1]), pk_bf16(ST[1][2], ST[1][3])});
            const bf16x8 s1 = __builtin_bit_cast(bf16x8, (u32x4){pk_bf16(ST[2][0], ST[2][1]), pk_bf16(ST[2][2], ST[2][3]), pk_bf16(ST[3][0], ST[3][1]), pk_bf16(ST[3][2], ST[3][3])});
            const bf16x8 at0 = *(LAS const bf16x8*)(sl + SC_AT + (fr * 32 + fq * 8) * 2), at1 = *(LAS const bf16x8*)(sl + SC_AT + ((16 + fr) * 32 + fq * 8) * 2);
            const bf16x8 rt0 = *(LAS const bf16x8*)(sl + SC_RT + (fr * 32 + fq * 8) * 2), rt1 = *(LAS const bf16x8*)(sl + SC_RT + ((16 + fr) * 32 + fq * 8) * 2);
            const int mo = (fr * 16 + 4 * fq) * 2;
            const bf16x8 vf = frag4(sl + SC_VP + mo), akf = frag4(sl + SC_AK + mo), xf = frag4(sl + SC_X + mo), rbf = frag4(sl + SC_RB + mo), rkf = frag4(sl + SC_RK + mo);
            const f32x4 z = (f32x4){0.f, 0.f, 0.f, 0.f};
            f32x4 g = __builtin_amdgcn_mfma_f32_16x16x32_bf16(at0, s0, z, 0, 0, 0);
            g = __builtin_amdgcn_mfma_f32_16x16x32_bf16(at1, s1, g, 0, 0, 0);
            g = __builtin_amdgcn_mfma_f32_16x16x32_bf16(akf, vf, g, 0, 0, 0);
            const f32x4 sa = __builtin_amdgcn_mfma_f32_16x16x32_bf16(xf, cfrag(g), z, 0, 0, 0);
            const bf16x8 saf = cfrag(sa);
            f32x4 y = __builtin_amdgcn_mfma_f32_16x16x32_bf16(rt0, s0, z, 0, 0, 0);
            y = __builtin_amdgcn_mfma_f32_16x16x32_bf16(rt1, s1, y, 0, 0, 0);
            y = __builtin_amdgcn_mfma_f32_16x16x32_bf16(rbf, saf, y, 0, 0, 0);
            y = __builtin_amdgcn_mfma_f32_16x16x32_bf16(rkf, vf, y, 0, 0, 0);
#pragma unroll
            for (int jt = 0; jt < 4; ++jt) {
                const f32x4 wc = *(LAS const f32x4*)(sl + SC_WC + (16 * jt + 4 * fq) * 4);
                const bf16x8 bb = frag4(sl + SC_BBT + ((16 * jt + fr) * SC_BS + 4 * fq) * 2), kb = frag4(sl + SC_KBT + ((16 * jt + fr) * SC_BS + 4 * fq) * 2);
                f32x4 acc = ST[jt];
                acc = __builtin_amdgcn_mfma_f32_16x16x32_bf16(bb, saf, acc, 0, 0, 0);
                acc = __builtin_amdgcn_mfma_f32_16x16x32_bf16(kb, vf, acc, 0, 0, 0);
                ST[jt] = acc * wc;
            }
#pragma unroll
            for (int r = 0; r < 4; ++r) Y[(tok0 + (size_t)c * 16 + 4 * fq + r) * 512 + h * 64 + rg * 16 + fr] = bf1(y[r]);
        };
        LAS unsigned char* scr = lds + SC_RING + (pw < 0 ? 0 : pw) * SC_SCR;
        if (wid >= 3) { pload(pw); pbuild(pw, lds + pw * SC_SLOT, scr, SC_NP + pw); }
        lds_barrier();
        for (int rd = 0; rd < NRD; ++rd) {
            if (wid == 0) {
#pragma unroll 1
                for (int q = 0; q < SC_NP; ++q) { const int c = rd * SC_NP + q; if (c < NCH) consume(c, lds + ((rd & 1) * SC_NP + q) * SC_SLOT); }
            } else if (wid >= 3) {
                const int cb = (rd + 1) * SC_NP + pw, cn = cb + SC_NP;
                if (cb < NCH) pbuild(cb, lds + (((rd + 1) & 1) * SC_NP + pw) * SC_SLOT, scr, cn < NCH ? cn : -1);
            }
            lds_barrier();
        }
        __syncthreads();
    }
}

__device__ __forceinline__ void phase_attn(const Params& p, int l, LAS unsigned char* ldsb) {
    unsigned char* R = p.ws + WS_R;
    const bf16_t* QKV = (const bf16_t*)(R + R_QKV); bf16_t* ATT = (bf16_t*)(R + R_ATT);
    const float* relb = p.in[7]; const float* sinks = p.in[8] + l * 8;
    const int tid = otid(), wid = tid >> 6, lane = tid & 63, fr = lane & 15, fq = lane >> 4;
    LAS bf16_t* Ks = (LAS bf16_t*)ldsb;
    LAS bf16_t* Vt = (LAS bf16_t*)(ldsb + 36864);
    LAS float* biasL = (LAS float*)(ldsb + 70656);
    LAS bf16_t* Pw = (LAS bf16_t*)(ldsb + 72704) + wid * (16 * 168);
    for (int item = obid(); item < 512; item += gridDim.x) {
        const int g = item & 1, n = (item >> 1) & 31, b = item >> 6;
        const long tokc = (long)b * SEQ + n * 128, tokp = tokc - 128;
        for (int idx = tid; idx < 2048; idx += 512) {
            const int key = idx >> 3, d8 = idx & 7; u32x4 v = (u32x4){0u, 0u, 0u, 0u}, kv = (u32x4){0u, 0u, 0u, 0u};
            if (n > 0 || key >= 128) { const bf16_t* src = QKV + (size_t)(tokp + key) * 768 + 512 + g * 64 + d8 * 8; kv = *(const u32x4*)src; v = *(const u32x4*)(src + 128); }
            *(LAS u32x4*)(Ks + key * 72 + d8 * 8) = kv;
#pragma unroll
            for (int e = 0; e < 8; ++e) Vt[(d8 * 8 + e) * 264 + key] = (bf16_t)((e & 1) ? (v[e >> 1] >> 16) : (v[e >> 1] & 0xffffu));
        }
        { const int hl = tid >> 7, d = tid & 127; int bk = d;
          if (d >= 16) { bk = 16 + (int)(__logf((float)d * 0.0625f) * (16.f / 2.07944154168f)); bk = bk > 31 ? 31 : bk; }
          biasL[tid] = relb[bk * 8 + g * 4 + hl]; }
        __syncthreads();
        const int hl = wid >> 1, hq = g * 4 + hl; const float sink = sinks[hq];
        for (int rt = 0; rt < 4; ++rt) {
            const int q0 = (wid & 1) * 64 + rt * 16, kstart = q0 < 96 ? q0 : 96;
            bf16x8 qa0, qa1; { const bf16_t* qp = QKV + (size_t)(tokc + q0 + fr) * 768 + hq * 64 + fq * 8; qa0 = *(const bf16x8*)qp; qa1 = *(const bf16x8*)(qp + 32); }
            f32x4 S[10];
#pragma unroll
            for (int kt = 0; kt < 10; ++kt) {
                LAS const bf16_t* kp = Ks + (kstart + kt * 16 + fr) * 72 + fq * 8;
                const bf16x8 k0 = *(LAS const bf16x8*)kp, k1 = *(LAS const bf16x8*)(kp + 32);
                f32x4 z = (f32x4){0.f, 0.f, 0.f, 0.f};
                z = __builtin_amdgcn_mfma_f32_16x16x32_bf16(qa0, k0, z, 0, 0, 0);
                z = __builtin_amdgcn_mfma_f32_16x16x32_bf16(qa1, k1, z, 0, 0, 0);
                S[kt] = z;
            }
            float mx[4] = {-INFINITY, -INFINITY, -INFINITY, -INFINITY};
#pragma unroll
            for (int kt = 0; kt < 10; ++kt)
#pragma unroll
                for (int j = 0; j < 4; ++j) {
                    const int key = kstart + kt * 16 + fr, dist = q0 + 4 * fq + j + 128 - key;
                    const bool ok = (dist >= 0) && (dist < 128) && (n > 0 || key >= 128);
                    const float s = ok ? (S[kt][j] * 0.125f + biasL[hl * 128 + (dist & 127)]) : -INFINITY;
                    S[kt][j] = s; mx[j] = fmaxf(mx[j], s);
                }
            float inv[4];
#pragma unroll
            for (int j = 0; j < 4; ++j) mx[j] = fmaxf(row16_max(mx[j]), sink);
            float sm[4] = {0.f, 0.f, 0.f, 0.f};
#pragma unroll
            for (int kt = 0; kt < 10; ++kt)
#pragma unroll
                for (int j = 0; j < 4; ++j) { const float e = __expf(S[kt][j] - mx[j]); S[kt][j] = e; sm[j] += e; }
#pragma unroll
            for (int j = 0; j < 4; ++j) inv[j] = 1.f / (row16_sum(sm[j]) + __expf(sink - mx[j]));
#pragma unroll
            for (int kt = 0; kt < 10; ++kt)
#pragma unroll
                for (int j = 0; j < 4; ++j) Pw[(4 * fq + j) * 168 + kt * 16 + fr] = (bf16_t)(pk_bf16(S[kt][j] * inv[j], 0.f) & 0xffffu);
            asm volatile("s_waitcnt lgkmcnt(0)" ::: "memory");
            __builtin_amdgcn_wave_barrier();
            f32x4 O[4];
#pragma unroll
            for (int dt = 0; dt < 4; ++dt) O[dt] = (f32x4){0.f, 0.f, 0.f, 0.f};
#pragma unroll
            for (int kk = 0; kk < 5; ++kk) {
                const bf16x8 pa = *(LAS const bf16x8*)(Pw + fr * 168 + kk * 32 + fq * 8);
#pragma unroll
                for (int dt = 0; dt < 4; ++dt) {
                    const bf16x8 vb = *(LAS const bf16x8*)(Vt + (dt * 16 + fr) * 264 + kstart + kk * 32 + fq * 8);
                    O[dt] = __builtin_amdgcn_mfma_f32_16x16x32_bf16(pa, vb, O[dt], 0, 0, 0);
                }
            }
#pragma unroll
            for (int dt = 0; dt < 4; ++dt)
#pragma unroll
                for (int j = 0; j < 4; ++j) ATT[(size_t)(tokc + q0 + 4 * fq + j) * 512 + hq * 64 + dt * 16 + fr] = (bf16_t)(pk_bf16(O[dt][j], 0.f) & 0xffffu);
            asm volatile("s_waitcnt lgkmcnt(0)" ::: "memory");
            __builtin_amdgcn_wave_barrier();
        }
        __syncthreads();
    }
}

__device__ __forceinline__ void phase_post(const Params& p, int l) {
    unsigned char* R = p.ws + WS_R;
    bf16_t* Y = (bf16_t*)(R + R_Y); const bf16_t* Vb = (const bf16_t*)(R + (l == 0 ? R_V : R_VNEW)); const bf16_t* G = (const bf16_t*)(R + R_G); const float* CB = (const float*)(R + R_CB);
    const float* gng = p.in[18] + (size_t)l * 512; const float* gnb = p.in[19] + (size_t)l * 512;
    const size_t total = (size_t)M_TOK * 64, nth = (size_t)gridDim.x * 512;
    const size_t it0 = (size_t)obid() * 512 + otid();
    const int c0 = (int)(it0 & 63) * 8, h = c0 >> 6;
    const f32x4 gg0 = *(const f32x4*)(gng + c0), gg1 = *(const f32x4*)(gng + c0 + 4), gb0 = *(const f32x4*)(gnb + c0), gb1 = *(const f32x4*)(gnb + c0 + 4);
    for (size_t it = it0; it < total; it += 2 * nth) {
        u32x4 yw[2], vw[2], gw[2]; float cb[2]; size_t row[2]; bool ok[2];
#pragma unroll
        for (int u = 0; u < 2; ++u) { const size_t iu = it + u * nth; ok[u] = iu < total; row[u] = (ok[u] ? iu : it) >> 6;
            yw[u] = *(const u32x4*)(Y + row[u] * 512 + c0); vw[u] = *(const u32x4*)(Vb + row[u] * 512 + c0); gw[u] = *(const u32x4*)(G + row[u] * 512 + c0); cb[u] = CB[row[u] * 8 + h]; }
#pragma unroll
        for (int u = 0; u < 2; ++u) {
            f32x4 y0, y1; unpack8(yw[u], y0, y1);
            float s = y0[0] + y0[1] + y0[2] + y0[3] + y1[0] + y1[1] + y1[2] + y1[3];
            s += dpp_f<0xB1>(s); s += dpp_f<0x4E>(s); s += dpp_f<0x141>(s);
            const float mu = s * (1.f / 64.f);
            y0 -= mu; y1 -= mu;
            float q = y0[0] * y0[0] + y0[1] * y0[1] + y0[2] * y0[2] + y0[3] * y0[3] + y1[0] * y1[0] + y1[1] * y1[1] + y1[2] * y1[2] + y1[3] * y1[3];
            q += dpp_f<0xB1>(q); q += dpp_f<0x4E>(q); q += dpp_f<0x141>(q);
            const float rs = rsqrtf(q * (1.f / 64.f) + 64e-5f);
            f32x4 v0, v1, g0, g1; unpack8(vw[u], v0, v1); unpack8(gw[u], g0, g1);
            const f32x4 o0 = (y0 * rs * gg0 + gb0 + v0 * cb[u]) * g0, o1 = (y1 * rs * gg1 + gb1 + v1 * cb[u]) * g1;
            if (ok[u]) *(u32x4*)(Y + row[u] * 512 + c0) = pack8(o0, o1);
        }
    }
}


#define XB_TMO      128
#define XB_XCNT(j)  (256  + 64 * (j))
#define XB_XSUB(j)  (1280 + 64 * (j))
#define XB_XGEN(j)  (2304 + 64 * (j))
#define XB_TOP      3328
#define XB_TOPGEN   3392
#define XCD_BAR_WORDS 3456
#define XB_SPIN_CAP (1u << 20)
__device__ __forceinline__ unsigned xb_ld(unsigned* p)              { return __hip_atomic_load(p, __ATOMIC_RELAXED, __HIP_MEMORY_SCOPE_AGENT); }
__device__ __forceinline__ unsigned xb_add(unsigned* p, unsigned v) { return __hip_atomic_fetch_add(p, v, __ATOMIC_RELAXED, __HIP_MEMORY_SCOPE_AGENT); }
__device__ __forceinline__ unsigned xb_xcc_id() { return (unsigned)__builtin_amdgcn_s_getreg((3 << 11) | 20) & 0xFu; }
#define XB_SPIN(cond, bar) do { unsigned _sp = 0; while (cond) { __builtin_amdgcn_s_sleep(1); \
    if ((++_sp & 255u) == 0u) { if (xb_ld(&(bar)[XB_TMO])) break; if (_sp > XB_SPIN_CAP) { atomicAdd(&(bar)[XB_TMO], 1u); break; } } } } while (0)
struct XcdBarrier { unsigned* bar; unsigned x; volatile LAS unsigned* st; };
__device__ __forceinline__ XcdBarrier xcd_barrier_post(unsigned* bar, volatile LAS unsigned* st) {
    XcdBarrier b; b.bar = bar; b.x = xb_xcc_id(); b.st = st;
    if (threadIdx.x == 0) (void)xb_add(&bar[XB_XCNT(b.x)], 1u);
    return b;
}
__device__ __forceinline__ void xcd_barrier_complete(unsigned* bar, unsigned x, unsigned& nloc, unsigned& nx) {
    const unsigned G = gridDim.x * gridDim.y * gridDim.z;
    unsigned sum, cnt, mine, sp = 0u;
    for (;;) {
        sum = 0u; cnt = 0u; mine = 0u;
#pragma unroll
        for (unsigned j = 0; j < 16; ++j) { const unsigned c = xb_ld(&bar[XB_XCNT(j)]); sum += c; cnt += (c > 0u) ? 1u : 0u; mine = (j == x) ? c : mine; }
        if (sum == G) break;
        __builtin_amdgcn_s_sleep(1);
        if ((++sp & 255u) == 0u) { if (xb_ld(&bar[XB_TMO])) break; if (sp > XB_SPIN_CAP) { atomicAdd(&bar[XB_TMO], 1u); break; } }
    }
    nloc = mine > 0u ? mine : 1u; nx = cnt > 0u ? cnt : 1u;
}
__device__ __forceinline__ void xcd_barrier(const XcdBarrier& b) {
    asm volatile("s_waitcnt vmcnt(0)" ::: "memory");
    __syncthreads();
    if (threadIdx.x == 0) {
        unsigned* bar = b.bar;
        __builtin_amdgcn_s_waitcnt(0);
        unsigned nloc = b.st[0], nx = b.st[1];
        if (nloc == 0u) { xcd_barrier_complete(bar, b.x, nloc, nx); b.st[0] = nloc; b.st[1] = nx; }
        const unsigned old = xb_add(&bar[XB_XSUB(b.x)], 1u);
        const unsigned gen = old / nloc;
        if (old + 1u == (gen + 1u) * nloc) {
            __builtin_amdgcn_fence(__ATOMIC_RELEASE, "agent");
            asm volatile("s_waitcnt vmcnt(0)" ::: "memory");
            const unsigned og = xb_add(&bar[XB_TOP], 1u);
            const unsigned tg = og / nx;
            if (og + 1u == (tg + 1u) * nx) xb_add(&bar[XB_TOPGEN], 1u);
            else XB_SPIN(xb_ld(&bar[XB_TOPGEN]) == tg, bar);
            __builtin_amdgcn_fence(__ATOMIC_ACQUIRE, "agent");
            xb_add(&bar[XB_XGEN(b.x)], 1u);
            asm volatile("s_waitcnt vmcnt(0)" ::: "memory");
        } else {
            XB_SPIN(xb_ld(&bar[XB_XGEN(b.x)]) == gen, bar);
            __builtin_amdgcn_fence(__ATOMIC_ACQUIRE, "agent");
            asm volatile("s_waitcnt vmcnt(0)" ::: "memory");
        }
    }
    __syncthreads();
}

__device__ __forceinline__ void gsync(cg::grid_group& grid) {
    asm volatile("s_waitcnt vmcnt(0) lgkmcnt(0)" ::: "memory");
    grid.sync();
    __builtin_amdgcn_fence(__ATOMIC_ACQUIRE, "agent");
    asm volatile("s_waitcnt vmcnt(0)" ::: "memory");
}
__global__ void __launch_bounds__(512, 2) fwd_kernel(Params p) {
    extern __shared__ __attribute__((aligned(16))) unsigned char shm[];
    LAS unsigned char* lds = (LAS unsigned char*)shm;
    cg::grid_group grid = cg::this_grid();
    unsigned char* R = p.ws + WS_R;
    const bf16_t* WB = (const bf16_t*)(p.ws + WS_WB);
    bf16_t* XB = (bf16_t*)(p.ws + WS_XB);

    volatile LAS unsigned* xst = (volatile LAS unsigned*)(lds + LDS_XB);
    if (threadIdx.x == 0) { xst[0] = 0u; xst[1] = 0u; }
    __syncthreads();
    const XcdBarrier xb = xcd_barrier_post((unsigned*)(p.ws + WS_BAR), xst);
    phase_cvt_x(p);
    phase_wprep(p, 0, (LAS float*)lds);
    gsync(grid);
#pragma unroll 1
    for (int hs = 0; hs < 4; ++hs) {
        const int l = hs >> 1, j = hs & 1;
        { Gemm g; g.A = XB; g.Bt = WB + (j ? WB_GU1 : WB_GU0); g.M = M_TOK; g.N = 5632; g.K = 1024;
          EpiGU e; e.H = (bf16_t*)(R + R_HB); gemm_phase(lds, g, e); }
        xcd_barrier(xb);
        { Gemm g; g.A = (const bf16_t*)(R + R_HB); g.Bt = WB + (j ? WB_D1 : WB_D0); g.M = M_TOK; g.N = 1024; g.K = 2816;
          EpiP<FDelta> e; e.f.D = (bf16_t*)(R + R_DEL); e.f.beta = 0.5f; gemm_phase(lds, g, e); }
        xcd_barrier(xb);
        { const int li = l * 3 + (j ? 2 : 0); phase_ln((hs == 0) ? p.in[0] : p.out, (const bf16_t*)(R + R_DEL), p.out, XB, p.in[3] + (size_t)li * 1024, p.in[4] + (size_t)li * 1024, hs != 3); }
        if (hs == 1) phase_wprep(p, 1, (LAS float*)lds);
        xcd_barrier(xb);
        if (j == 0) {
            { Gemm g; g.A = XB; g.Bt = WB + WB_IN + (size_t)2048 * 1024; g.M = M_TOK; g.N = 2560; g.K = 1024;
              EpiP<FProj> e; e.f.QKV = (bf16_t*)(R + R_QKV); e.f.U = (bf16_t*)(R + R_U); e.f.bias = p.in[6] + (size_t)l * 4608 + 2048; gemm_phase(lds, g, e); }
            xcd_barrier(xb);
            phase_prep(p, l);
            xcd_barrier(xb);
            { Gemm g; g.A = (const bf16_t*)(R + R_AP); g.Bt = WB + WB_LR; g.M = M_TOK; g.N = 1536; g.K = 256;
              EpiP<FLowRank> e; e.f.EW = (_Float16*)(R + R_EW); e.f.A = (bf16_t*)(R + R_A); e.f.G = (bf16_t*)(R + R_G); e.f.w0 = p.in[10] + (size_t)l * 512; e.f.a0 = p.in[12] + (size_t)l * 512;
              gemm_phase(lds, g, e); }
            if (l >= 1) {
                Gemm g; g.A = (const bf16_t*)(R + R_V); g.Bt = WB + WB_V12; g.M = M_TOK; g.N = 512; g.K = 512;
                EpiP<FVmix> e; e.f.V = (const bf16_t*)(R + R_V); e.f.VF = (const bf16_t*)(p.ws + WS_VF); e.f.VN = (bf16_t*)(R + R_VNEW); e.f.v0p = p.in[20] + (size_t)(l - 1) * 512;
                gemm_phase(lds, g, e);
            }
            xcd_barrier(xb);
            phase_scan2(p, l, lds);
            phase_attn(p, l, lds);
            xcd_barrier(xb);
            phase_post(p, l);
            { Gemm g; g.A = XB; g.Bt = WB + WB_IN; g.M = M_TOK; g.N = 2048; g.K = 1024;
              EpiP<FGates> e; e.f.GA = (bf16_t*)(R + R_GA); e.f.GB = (bf16_t*)(R + R_GB); e.f.bias = p.in[6] + (size_t)l * 4608; gemm_phase(lds, g, e); }
            xcd_barrier(xb);
            { Gemm g; g.A = (const bf16_t*)(R + R_ATT); g.Bt = WB + WB_BA; g.M = M_TOK; g.N = 1024; g.K = 512;
              EpiP<FBranch<false>> e; e.f.GT = (const bf16_t*)(R + R_GA); e.f.MB = (bf16_t*)(R + R_MB); gemm_phase(lds, g, e); }
            asm volatile("s_waitcnt vmcnt(0)" ::: "memory");
            { Gemm g; g.A = (const bf16_t*)(R + R_Y); g.Bt = WB + WB_BB; g.M = M_TOK; g.N = 1024; g.K = 512;
              EpiP<FBranch<true>> e; e.f.GT = (const bf16_t*)(R + R_GB); e.f.MB = (bf16_t*)(R + R_MB); gemm_phase(lds, g, e); }
            xcd_barrier(xb);
            { Gemm g; g.A = (const bf16_t*)(R + R_MB); g.Bt = WB + WB_O; g.M = M_TOK; g.N = 1024; g.K = 1024;
              EpiP<FDelta> e; e.f.D = (bf16_t*)(R + R_DEL); e.f.beta = 1.0f; gemm_phase(lds, g, e); }
            xcd_barrier(xb);
            { const int li = l * 3 + 1; phase_ln(p.out, (const bf16_t*)(R + R_DEL), p.out, XB, p.in[3] + (size_t)li * 1024, p.in[4] + (size_t)li * 1024, true); }
            xcd_barrier(xb);
        }
    }
}

extern "C" void kernel_launch(void* const* d_in, const int* in_sizes, int n_in, void* d_out, int out_size, void* d_ws, size_t ws_size, hipStream_t stream) {
    static int grid = 0;
    if (grid == 0) {
        if (n_in != 26 || ws_size < WS_END) { grid = -1; return; }
        int dev = 0, cus = 0, per_cu = 0;
        (void)hipGetDevice(&dev);
        (void)hipDeviceGetAttribute(&cus, hipDeviceAttributeMultiprocessorCount, dev);
        (void)hipFuncSetAttribute((const void*)fwd_kernel, hipFuncAttributeMaxDynamicSharedMemorySize, LDS_BYTES);
        if (hipOccupancyMaxActiveBlocksPerMultiprocessor(&per_cu, (const void*)fwd_kernel, 512, LDS_BYTES) != hipSuccess || per_cu < 1) per_cu = 1;
        (void)hipGetLastError();
        grid = cus * 1;
        if (grid <= 0) grid = 256;
    }
    if (grid < 0) return;
    (void)hipMemsetAsync((unsigned char*)d_ws + WS_BAR, 0, XCD_BAR_WORDS * sizeof(unsigned), stream);
    Params p{};
    for (int i = 0; i < 26; ++i) p.in[i] = (const float*)d_in[i];
    p.out = (float*)d_out; p.ws = (unsigned char*)d_ws;
    void* args[] = {&p};
    (void)hipLaunchCooperativeKernel((const void*)fwd_kernel, dim3(grid), dim3(512), args, LDS_BYTES, stream);
}
```

```cpp
#include <hip/hip_runtime.h>
#include <hip/hip_cooperative_groups.h>
#include <math.h>
namespace cg = cooperative_groups;

#define LAS __attribute__((address_space(3)))
typedef unsigned short bf16_t;
typedef short bf16x8 __attribute__((ext_vector_type(8)));
typedef float f32x4 __attribute__((ext_vector_type(4)));
typedef unsigned u32x4 __attribute__((ext_vector_type(4)));
typedef unsigned u32x2 __attribute__((ext_vector_type(2)));

constexpr int M_TOK = 32768, SEQ = 4096;
constexpr float ALPHA = 1.41421356237f;
constexpr int LDS_XB = 153600;
constexpr int LDS_BYTES = LDS_XB + 16;

constexpr size_t MiB = 1u << 20;
constexpr size_t WS_WB = 0, WS_XB = 48 * MiB, WS_VF = 112 * MiB, WS_R = 144 * MiB, WS_END = 512 * MiB, WS_BAR = 47 * MiB + 512 * 1024;
constexpr size_t R_HB = 0, R_QKV = 0, R_U = 48 * MiB, R_VNEW = 48 * MiB, R_Y = 80 * MiB, R_ATT = 112 * MiB, R_CB = 144 * MiB,
                 R_R = 160 * MiB, R_K = 192 * MiB, R_V = 224 * MiB, R_AP = 256 * MiB, R_EW = 272 * MiB, R_A = 304 * MiB, R_G = 336 * MiB,
                 R_DEL = 176 * MiB, R_GA = 160 * MiB, R_GB = 256 * MiB, R_MB = 0;
constexpr size_t WB_GU0 = 0, WB_GU1 = 5767168, WB_D0 = 11534336, WB_D1 = 14417920, WB_IN = 17301504, WB_BA = 22020096, WB_BB = 22544384,
                 WB_O = 23068672, WB_LR = 24117248, WB_V12 = 24510464;

struct Params {
    const float* in[26];
    float* out;
    unsigned char* ws;
};

typedef __bf16 bf16x2_t __attribute__((ext_vector_type(2)));
typedef float f32x2_t __attribute__((ext_vector_type(2)));
__device__ __forceinline__ unsigned pk_bf16(float lo, float hi) { const f32x2_t f = {lo, hi}; return __builtin_bit_cast(unsigned, __builtin_convertvector(f, bf16x2_t)); }
__device__ __forceinline__ float bf_lo(unsigned w) { return __uint_as_float(w << 16); }
__device__ __forceinline__ float bf_hi(unsigned w) { return __uint_as_float(w & 0xffff0000u); }
__device__ __forceinline__ float bf2f(bf16_t b) { return __uint_as_float(((unsigned)b) << 16); }
__device__ __forceinline__ float sigm(float x) { return __builtin_amdgcn_rcpf(1.f + __expf(-x)); }
__device__ __forceinline__ int otid() { int t = threadIdx.x; asm volatile("" : "+v"(t)); return t; }
__device__ __forceinline__ int obid() { int b = blockIdx.x; asm volatile("" : "+s"(b)); return b; }
__device__ __forceinline__ float wave_sum(float x);
template <int CTRL> __device__ __forceinline__ float dpp_f(float x) { return __builtin_bit_cast(float, __builtin_amdgcn_mov_dpp(__builtin_bit_cast(int, x), CTRL, 0xF, 0xF, true)); }
__device__ __forceinline__ float row16_sum(float x) {
    x += dpp_f<0xB1>(x); x += dpp_f<0x4E>(x); x += dpp_f<0x141>(x); x += dpp_f<0x140>(x); return x;
}
__device__ __forceinline__ float row16_max(float x) {
    x = fmaxf(x, dpp_f<0xB1>(x)); x = fmaxf(x, dpp_f<0x4E>(x)); x = fmaxf(x, dpp_f<0x141>(x)); x = fmaxf(x, dpp_f<0x140>(x)); return x;
}
__device__ __forceinline__ float wave_sum(float x) {
    x = row16_sum(x);
    const int xi = __builtin_bit_cast(int, x);
    const float a = __builtin_bit_cast(float, __builtin_amdgcn_readlane(xi, 0)), b = __builtin_bit_cast(float, __builtin_amdgcn_readlane(xi, 16)),
                c = __builtin_bit_cast(float, __builtin_amdgcn_readlane(xi, 32)), d = __builtin_bit_cast(float, __builtin_amdgcn_readlane(xi, 48));
    return (a + b) + (c + d);
}

constexpr int BM = 256, BK = 64, HALF = 128, HTB = HALF * BK * 2, NXCD = 8, WGM = 8;
__device__ __forceinline__ int lds_byte(int r, int c) { const int st = (r >> 4) * 2 + (c >> 5), rr = r & 15, cc = c & 31, ob = rr * 64 + cc * 2; return st * 1024 + (ob ^ (((ob >> 9) & 1) << 5)); }
__device__ __forceinline__ void stage_rc(int b, int& R, int& C) { const int st = b / 1024, sb = b % 1024, swz = sb ^ (((sb >> 9) & 1) << 5); R = (st >> 1) * 16 + swz / 64; C = (st & 1) * 32 + (swz % 64) / 2; }
__device__ __forceinline__ int perm32(int rho) { const int n = rho >> 4, i = rho & 15; return 8 * (i >> 2) + 4 * n + (i & 3); }

struct Unit { int pm, pn; };
struct Gemm { const bf16_t* A; const bf16_t* Bt; int M, N, K; };
struct StaticOrder {
    int nM, nN, nwg, G, c;
    __device__ void init(int M, int N, int G_, int c_) { nM = M / BM; nN = N / BM; nwg = nM * nN; G = G_; c = c_; }
    __device__ bool next(int i, Unit& u) const {
        const long L = (long)i * G + c; if (L >= nwg) return false;
        int wgid = (int)L; { const int q = nwg / NXCD, r = nwg % NXCD, xcd = wgid % NXCD, off = wgid / NXCD; wgid = (xcd < r ? xcd * (q + 1) : r * (q + 1) + (xcd - r) * q) + off; }
        const int nig = WGM * nN, gid = wgid / nig, fm = gid * WGM, gsz = (nM - fm) < WGM ? (nM - fm) : WGM;
        u.pm = fm + ((wgid % nig) % gsz); u.pn = (wgid % nig) / gsz; return true;
    }
};

template <class Epi>
__device__ __forceinline__ void gemm_phase(LAS unsigned char* lds, const Gemm g, const Epi& E) {
    const int tid = otid(), wid = __builtin_amdgcn_readfirstlane(tid >> 6), lane = tid & 63, wr = wid >> 2, wc = wid & 3, fr = lane & 15, fq = lane >> 4;
    int Kop = g.K; asm volatile("" : "+s"(Kop));
    const int K = Kop, nt = K / BK;
    StaticOrder S; S.init(g.M, g.N, (int)gridDim.x, obid());
    unsigned voffA[2], voffB[2];
#pragma unroll
    for (int i = 0; i < 2; ++i) { int R, C; stage_rc(tid * 16 + i * 8192, R, C); const int Rb = Epi::PERM ? ((R & ~31) + perm32(R & 31)) : R;
        voffA[i] = (unsigned)(R * K + C) * 2u; voffB[i] = (unsigned)(Rb * K + C) * 2u; }
    const size_t kstep = (size_t)(BK * 2);
    const size_t hstep = (size_t)HALF * K * 2;
    const size_t tstep = 2 * hstep;
    const unsigned ldsw = (unsigned)wid * 1024u;
    const int aoff = lds_byte(wr * 64 + fr, fq * 8), boff = lds_byte(wc * 32 + fr, fq * 8);
#define PG8_SA(b, h) (((b) * 2 + (h)) * HTB)
#define PG8_SB(b, h) ((4 + (b) * 2 + (h)) * HTB)
#define PG8_STAGE(bufoff, gbase, voff) do { _Pragma("unroll") for (int _i = 0; _i < 2; ++_i) \
        __builtin_amdgcn_global_load_lds((const unsigned*)((const char*)(gbase) + (voff)[_i]), (LAS unsigned*)(lds + (bufoff) + ldsw + _i * 8192), 16, 0, 0); } while (0)
#define PG8_LDA(dst, b, h) do { _Pragma("unroll") for (int m = 0; m < 4; ++m) _Pragma("unroll") for (int k = 0; k < 2; ++k) dst[m][k] = *(const LAS bf16x8*)(lds + PG8_SA(b, h) + aoff + m * 2048 + k * 1024); } while (0)
#define PG8_LDB(dst, b, h) do { _Pragma("unroll") for (int n = 0; n < 2; ++n) _Pragma("unroll") for (int k = 0; k < 2; ++k) dst[n][k] = *(const LAS bf16x8*)(lds + PG8_SB(b, h) + boff + n * 2048 + k * 1024); } while (0)
#define PG8_MMA(ai, bj, At, Bt) do { __builtin_amdgcn_s_setprio(1); _Pragma("unroll") for (int m = 0; m < 4; ++m) _Pragma("unroll") for (int n = 0; n < 2; ++n) _Pragma("unroll") for (int k = 0; k < 2; ++k) \
        acc[ai][bj][m][n] = __builtin_amdgcn_mfma_f32_16x16x32_bf16(Bt[n][k], At[m][k], acc[ai][bj][m][n], 0, 0, 0); __builtin_amdgcn_s_setprio(0); } while (0)
#define PG8_WAIT_V(n) asm volatile("s_waitcnt vmcnt(" #n ")" ::: "memory")
#define PG8_WAIT_L(n) asm volatile("s_waitcnt lgkmcnt(" #n ")" ::: "memory")
#define PG8_BAR __builtin_amdgcn_s_barrier()
#define PG8_SCHED __builtin_amdgcn_sched_barrier(0)
    Unit cur, nxt; int ui = 0;
    if (!S.next(0, cur)) return;
    f32x4 acc[2][2][4][2];
#pragma unroll
    for (int a = 0; a < 2; ++a)
#pragma unroll
        for (int b = 0; b < 2; ++b)
#pragma unroll
            for (int m = 0; m < 4; ++m)
#pragma unroll
                for (int n = 0; n < 2; ++n) acc[a][b][m][n] = (f32x4){0.f, 0.f, 0.f, 0.f};
    bf16x8 At[4][2], B0[2][2], B1[2][2];
    const char* cA = (const char*)g.A + (size_t)cur.pm * tstep; const char* cB = (const char*)g.Bt + (size_t)cur.pn * tstep;
    PG8_STAGE(PG8_SB(0, 0), cB, voffB); PG8_STAGE(PG8_SA(0, 0), cA, voffA); PG8_STAGE(PG8_SB(0, 1), cB + hstep, voffB); PG8_STAGE(PG8_SA(0, 1), cA + hstep, voffA);
    if (wr == 1) PG8_BAR;
    PG8_WAIT_V(4); PG8_BAR;
    PG8_STAGE(PG8_SB(1, 0), cB + kstep, voffB); PG8_STAGE(PG8_SA(1, 0), cA + kstep, voffA); PG8_STAGE(PG8_SB(1, 1), cB + hstep + kstep, voffB);
    PG8_WAIT_V(6); PG8_BAR;
    for (;;) {
        const bool has_next = S.next(ui + 1, nxt);
        const char* nA = has_next ? (const char*)g.A + (size_t)nxt.pm * tstep : cA; const char* nB = has_next ? (const char*)g.Bt + (size_t)nxt.pn * tstep : cB;
#pragma unroll 1
        for (int t = 0; t < nt; t += 2) {
            const bool last = (t == nt - 2);
            const char* a1 = cA + (size_t)(t + 1) * kstep;
            const char* a2 = last ? nA : cA + (size_t)(t + 2) * kstep; const char* b2 = last ? nB : cB + (size_t)(t + 2) * kstep;
            const char* a3 = a2 + kstep; const char* b3 = b2 + kstep;
            PG8_LDB(B0, 0, 0); PG8_SCHED; PG8_LDA(At, 0, 0); PG8_STAGE(PG8_SA(1, 1), a1 + hstep, voffA);
            PG8_WAIT_L(8); PG8_BAR; PG8_WAIT_L(0); PG8_MMA(0, 0, At, B0); PG8_BAR; PG8_SCHED;
            PG8_LDB(B1, 0, 1); PG8_STAGE(PG8_SB(0, 0), b2, voffB);
            PG8_BAR; PG8_WAIT_L(0); PG8_MMA(0, 1, At, B1); PG8_BAR;
            PG8_LDA(At, 0, 1); PG8_STAGE(PG8_SA(0, 0), a2, voffA);
            PG8_BAR; PG8_WAIT_L(0); PG8_MMA(1, 0, At, B0); PG8_BAR; PG8_SCHED;
            PG8_STAGE(PG8_SB(0, 1), b2 + hstep, voffB);
            PG8_WAIT_V(6); PG8_BAR; PG8_MMA(1, 1, At, B1); PG8_BAR;
            PG8_LDB(B0, 1, 0); PG8_SCHED; PG8_LDA(At, 1, 0); PG8_STAGE(PG8_SA(0, 1), a2 + hstep, voffA);
            PG8_WAIT_L(8); PG8_BAR; PG8_WAIT_L(0); PG8_MMA(0, 0, At, B0); PG8_BAR; PG8_SCHED;
            PG8_LDB(B1, 1, 1); PG8_STAGE(PG8_SB(1, 0), b3, voffB);
            PG8_BAR; PG8_WAIT_L(0); PG8_MMA(0, 1, At, B1); PG8_BAR;
            PG8_LDA(At, 1, 1); PG8_STAGE(PG8_SA(1, 0), a3, voffA);
            PG8_BAR; PG8_WAIT_L(0); PG8_MMA(1, 0, At, B0); PG8_BAR; PG8_SCHED;
            PG8_STAGE(PG8_SB(1, 1), b3 + hstep, voffB);
            PG8_WAIT_V(6); PG8_BAR; PG8_MMA(1, 1, At, B1); PG8_BAR;
        }
        { int fr2 = fr, fq2 = fq; asm volatile("" : "+v"(fr2), "+v"(fq2)); E(acc, cur, wr, wc, fr2, fq2); }
        if (!has_next) break;
#pragma unroll
        for (int a = 0; a < 2; ++a)
#pragma unroll
            for (int b = 0; b < 2; ++b)
#pragma unroll
                for (int m = 0; m < 4; ++m)
#pragma unroll
                    for (int n = 0; n < 2; ++n) acc[a][b][m][n] = (f32x4){0.f, 0.f, 0.f, 0.f};
        cur = nxt; cA = nA; cB = nB; ++ui;
    }
    PG8_WAIT_V(0);
    if (wr == 0) PG8_BAR;
    PG8_BAR;
#undef PG8_SA
#undef PG8_SB
#undef PG8_STAGE
#undef PG8_LDA
#undef PG8_LDB
#undef PG8_MMA
#undef PG8_WAIT_V
#undef PG8_WAIT_L
#undef PG8_BAR
#undef PG8_SCHED
}

struct EpiGU {
    static constexpr bool PERM = false;
    bf16_t* H;
    __device__ __forceinline__ void operator()(const f32x4 (&acc)[2][2][4][2], const Unit& u, int wr, int wc, int fr, int fq) const {
        const int row0 = u.pm * BM + wr * 64 + fr, col0 = u.pn * 128 + wc * 32 + fq * 8;
#pragma unroll
        for (int ai = 0; ai < 2; ++ai)
#pragma unroll
            for (int m = 0; m < 4; ++m) {
                float h[8];
#pragma unroll
                for (int bj = 0; bj < 2; ++bj)
#pragma unroll
                    for (int j = 0; j < 4; ++j) { const float gt = acc[ai][bj][m][0][j], up = acc[ai][bj][m][1][j]; h[bj * 4 + j] = gt * sigm(gt) * up; }
                u32x4 w; w.x = pk_bf16(h[0], h[1]); w.y = pk_bf16(h[2], h[3]); w.z = pk_bf16(h[4], h[5]); w.w = pk_bf16(h[6], h[7]);
                *(u32x4*)(H + (size_t)(row0 + ai * HALF + m * 16) * 2816 + col0) = w;
            }
    }
};
struct EpiRes {
    static constexpr bool PERM = false;
    const float* res; float* out; float alpha, beta;
    __device__ __forceinline__ void operator()(const f32x4 (&acc)[2][2][4][2], const Unit& u, int wr, int wc, int fr, int fq) const {
        const int row0 = u.pm * BM + wr * 64 + fr, col0 = u.pn * BM + wc * 32 + 4 * fq;
#pragma unroll
        for (int ai = 0; ai < 2; ++ai)
#pragma unroll
            for (int mp = 0; mp < 2; ++mp) {
                f32x4 x[2][2][2];
#pragma unroll
                for (int mm = 0; mm < 2; ++mm)
#pragma unroll
                    for (int bj = 0; bj < 2; ++bj)
#pragma unroll
                        for (int n = 0; n < 2; ++n) x[mm][bj][n] = *(const f32x4*)(res + (size_t)(row0 + ai * HALF + (mp * 2 + mm) * 16) * 1024 + col0 + bj * HALF + n * 16);
#pragma unroll
                for (int mm = 0; mm < 2; ++mm)
#pragma unroll
                    for (int bj = 0; bj < 2; ++bj)
#pragma unroll
                        for (int n = 0; n < 2; ++n) *(f32x4*)(out + (size_t)(row0 + ai * HALF + (mp * 2 + mm) * 16) * 1024 + col0 + bj * HALF + n * 16) = x[mm][bj][n] * alpha + acc[ai][bj][mp * 2 + mm][n] * beta;
            }
    }
};
template <class F> struct EpiP {
    static constexpr bool PERM = true;
    F f;
    __device__ __forceinline__ void operator()(const f32x4 (&acc)[2][2][4][2], const Unit& u, int wr, int wc, int fr, int fq) const {
        const int row0 = u.pm * BM + wr * 64 + fr, cb0 = u.pn * BM + wc * 32 + 8 * fq;
        typename F::Col cv[2];
#pragma unroll
        for (int bj = 0; bj < 2; ++bj) cv[bj] = f.col(cb0 + bj * HALF, u.pn);
#pragma unroll
        for (int ai = 0; ai < 2; ++ai)
#pragma unroll
          for (int mp = 0; mp < 2; ++mp) {
            typename F::Pos pv[2][2];
#pragma unroll
            for (int mm = 0; mm < 2; ++mm)
#pragma unroll
                for (int bj = 0; bj < 2; ++bj) pv[mm][bj] = f.pos(row0 + ai * HALF + (mp * 2 + mm) * 16, cb0 + bj * HALF, u.pn);
#pragma unroll
            for (int mm = 0; mm < 2; ++mm)
#pragma unroll
                for (int bj = 0; bj < 2; ++bj) f.fin(row0 + ai * HALF + (mp * 2 + mm) * 16, cb0 + bj * HALF, acc[ai][bj][mp * 2 + mm][0], acc[ai][bj][mp * 2 + mm][1], u.pn, cv[bj], pv[mm][bj]);
          }
    }
};
struct Col8 { f32x4 a, b; };
struct None {};
__device__ __forceinline__ u32x4 pack8(const f32x4 a, const f32x4 b) { u32x4 w; w.x = pk_bf16(a[0], a[1]); w.y = pk_bf16(a[2], a[3]); w.z = pk_bf16(b[0], b[1]); w.w = pk_bf16(b[2], b[3]); return w; }
__device__ __forceinline__ void unpack8(const u32x4 w, f32x4& a, f32x4& b) { a[0] = bf_lo(w.x); a[1] = bf_hi(w.x); a[2] = bf_lo(w.y); a[3] = bf_hi(w.y); b[0] = bf_lo(w.z); b[1] = bf_hi(w.z); b[2] = bf_lo(w.w); b[3] = bf_hi(w.w); }
__device__ __forceinline__ f32x4 sigm4(const f32x4 x) { f32x4 r; r[0] = sigm(x[0]); r[1] = sigm(x[1]); r[2] = sigm(x[2]); r[3] = sigm(x[3]); return r; }

struct FProj {
    typedef Col8 Col; typedef None Pos;
    bf16_t* QKV; bf16_t* U; const float* bias;
    __device__ __forceinline__ Col col(int cb, int) const { Col c; c.a = *(const f32x4*)(bias + cb); c.b = *(const f32x4*)(bias + cb + 4); return c; }
    __device__ __forceinline__ Pos pos(int, int, int) const { return None{}; }
    __device__ __forceinline__ void fin(int row, int cb, f32x4 v0, f32x4 v1, int pn, const Col& c, const Pos&) const {
        bf16_t* dst = (pn < 3) ? (QKV + (size_t)row * 768 + cb) : (U + (size_t)row * 1792 + (cb - 768));
        *(u32x4*)dst = pack8(v0 + c.a, v1 + c.b);
    }
};
struct FLowRank {
    typedef Col8 Col; typedef None Pos;
    _Float16* EW; bf16_t* A; bf16_t* G; const float* w0; const float* a0;
    __device__ __forceinline__ Col col(int cb, int pn) const { Col c; const float* src = (pn < 2) ? (w0 + cb) : (a0 + ((cb - 512) & 511)); c.a = *(const f32x4*)src; c.b = *(const f32x4*)(src + 4); return c; }
    __device__ __forceinline__ Pos pos(int, int, int) const { return None{}; }
    __device__ __forceinline__ void fin(int row, int cb, f32x4 v0, f32x4 v1, int pn, const Col& c, const Pos&) const {
        if (pn < 2) {
            v0 = sigm4(v0 + c.a) * 0.60653065971f; v1 = sigm4(v1 + c.b) * 0.60653065971f;
            typedef _Float16 h8 __attribute__((ext_vector_type(8)));
            h8 o; o[0] = (_Float16)v0[0]; o[1] = (_Float16)v0[1]; o[2] = (_Float16)v0[2]; o[3] = (_Float16)v0[3]; o[4] = (_Float16)v1[0]; o[5] = (_Float16)v1[1]; o[6] = (_Float16)v1[2]; o[7] = (_Float16)v1[3];
            *(h8*)(EW + (size_t)row * 512 + cb) = o;
        } else if (pn < 4) {
            *(u32x4*)(A + (size_t)row * 512 + (cb - 512)) = pack8(sigm4(v0 + c.a), sigm4(v1 + c.b));
        } else {
            *(u32x4*)(G + (size_t)row * 512 + (cb - 1024)) = pack8(v0, v1);
        }
    }
};
struct FDelta {
    typedef None Col; typedef None Pos;
    bf16_t* D; float beta;
    __device__ __forceinline__ Col col(int, int) const { return None{}; }
    __device__ __forceinline__ Pos pos(int, int, int) const { return None{}; }
    __device__ __forceinline__ void fin(int row, int cb, f32x4 v0, f32x4 v1, int, const Col&, const Pos&) const {
        *(u32x4*)(D + (size_t)row * 1024 + cb) = pack8(v0 * beta, v1 * beta);
    }
};
struct Pos2 { u32x4 a, b; };
struct FVmix {
    typedef Col8 Col; typedef Pos2 Pos;
    const bf16_t* V; const bf16_t* VF; bf16_t* VN; const float* v0p;
    __device__ __forceinline__ Col col(int cb, int) const { Col c; c.a = *(const f32x4*)(v0p + cb); c.b = *(const f32x4*)(v0p + cb + 4); return c; }
    __device__ __forceinline__ Pos pos(int row, int cb, int) const { Pos q; q.a = *(const u32x4*)(V + (size_t)row * 512 + cb); q.b = *(const u32x4*)(VF + (size_t)row * 512 + cb); return q; }
    __device__ __forceinline__ void fin(int row, int cb, f32x4 v0, f32x4 v1, int, const Col& c, const Pos& q) const {
        const f32x4 s0 = sigm4(v0 + c.a), s1 = sigm4(v1 + c.b);
        f32x4 a0, a1, f0, f1; unpack8(q.a, a0, a1); unpack8(q.b, f0, f1);
        *(u32x4*)(VN + (size_t)row * 512 + cb) = pack8(a0 + (f0 - a0) * s0, a1 + (f1 - a1) * s1);
    }
};
struct FGates {
    typedef Col8 Col; typedef None Pos;
    bf16_t* GA; bf16_t* GB; const float* bias;
    __device__ __forceinline__ Col col(int cb, int) const { Col c; c.a = *(const f32x4*)(bias + cb); c.b = *(const f32x4*)(bias + cb + 4); return c; }
    __device__ __forceinline__ Pos pos(int, int, int) const { return None{}; }
    __device__ __forceinline__ void fin(int row, int cb, f32x4 v0, f32x4 v1, int pn, const Col& c, const Pos&) const {
        bf16_t* dst = (pn < 4) ? (GA + (size_t)row * 1024 + cb) : (GB + (size_t)row * 1024 + (cb - 1024));
        *(u32x4*)dst = pack8(sigm4(v0 + c.a), sigm4(v1 + c.b));
    }
};
template <bool ADD> struct FBranch {
    typedef None Col; typedef Pos2 Pos;
    const bf16_t* GT; bf16_t* MB;
    __device__ __forceinline__ Col col(int, int) const { return None{}; }
    __device__ __forceinline__ Pos pos(int row, int cb, int) const { Pos q; q.a = *(const u32x4*)(GT + (size_t)row * 1024 + cb); q.b = ADD ? *(const u32x4*)(MB + (size_t)row * 1024 + cb) : (u32x4){0u, 0u, 0u, 0u}; return q; }
    __device__ __forceinline__ void fin(int row, int cb, f32x4 v0, f32x4 v1, int, const Col&, const Pos& q) const {
        f32x4 g0, g1; unpack8(q.a, g0, g1);
        f32x4 r0 = g0 * v0, r1 = g1 * v1;
        if (ADD) { f32x4 m0, m1; unpack8(q.b, m0, m1); r0 += m0; r1 += m1; }
        *(u32x4*)(MB + (size_t)row * 1024 + cb) = pack8(r0, r1);
    }
};

__device__ __forceinline__ int gu_row(int c) {
    const int nn = c >= 2816 ? 1 : 0, hc = c - 2816 * nn, pn = hc >> 7, rem = hc & 127, wc = rem >> 5, r5 = rem & 31, ih = r5 >> 3, bj = (r5 >> 2) & 1, il = r5 & 3;
    return 256 * pn + bj * 128 + wc * 32 + nn * 16 + ih * 4 + il;
}
__device__ __forceinline__ void wtrans(const float* __restrict__ src, int K, int N, bf16_t* __restrict__ dst, int ldd, int mode, LAS float* tile) {
    const int tid = otid(), tn = N >> 6, nt = (K >> 6) * tn;
    for (int t = obid(); t < nt; t += gridDim.x) {
        const int k0 = (t / tn) << 6, c0 = (t % tn) << 6;
        {
#pragma unroll
          for (int i = 0; i < 2; ++i) { const int e = tid + 512 * i, kl = e >> 4, c4 = (e & 15) * 4;
              const f32x4 v4 = *(const f32x4*)(src + (size_t)(k0 + kl) * N + c0 + c4);
              tile[kl * 65 + c4] = v4[0]; tile[kl * 65 + c4 + 1] = v4[1]; tile[kl * 65 + c4 + 2] = v4[2]; tile[kl * 65 + c4 + 3] = v4[3]; } }
        __syncthreads();
        { const int kp = tid & 31, cl0 = tid >> 5;
#pragma unroll
          for (int i = 0; i < 4; ++i) { const int cl = cl0 + 16 * i, c = c0 + cl; const int R = mode ? gu_row(c) : c;
              *(unsigned*)(dst + (size_t)R * ldd + k0 + 2 * kp) = pk_bf16(tile[(2 * kp) * 65 + cl], tile[(2 * kp + 1) * 65 + cl]); } }
        __syncthreads();
    }
}
__device__ __forceinline__ void phase_wprep(const Params& p, int l, LAS float* tile) {
    bf16_t* WB = (bf16_t*)(p.ws + WS_WB);
    wtrans(p.in[1] + (size_t)(l * 2 + 0) * 1024 * 5632, 1024, 5632, WB + WB_GU0, 1024, 1, tile);
    wtrans(p.in[1] + (size_t)(l * 2 + 1) * 1024 * 5632, 1024, 5632, WB + WB_GU1, 1024, 1, tile);
    wtrans(p.in[2] + (size_t)(l * 2 + 0) * 2816 * 1024, 2816, 1024, WB + WB_D0, 2816, 0, tile);
    wtrans(p.in[2] + (size_t)(l * 2 + 1) * 2816 * 1024, 2816, 1024, WB + WB_D1, 2816, 0, tile);
    wtrans(p.in[5] + (size_t)l * 1024 * 4608, 1024, 4608, WB + WB_IN, 1024, 0, tile);
    wtrans(p.in[23] + (size_t)l * 512 * 1024, 512, 1024, WB + WB_BA, 512, 0, tile);
    wtrans(p.in[24] + (size_t)l * 512 * 1024, 512, 1024, WB + WB_BB, 512, 0, tile);
    wtrans(p.in[25] + (size_t)l * 1024 * 1024, 1024, 1024, WB + WB_O, 1024, 0, tile);
    const int gt = obid() * 512 + otid(), nth = gridDim.x * 512;
    {
        const float* w2 = p.in[11] + (size_t)l * 64 * 512; const float* a2 = p.in[13] + (size_t)l * 64 * 512; const float* g2 = p.in[14] + (size_t)l * 128 * 512;
        for (int idx = gt; idx < 1536 * 256; idx += nth) { const int n = idx >> 8, k = idx & 255; float v = 0.f;
            if (n < 512) { if (k < 64) v = w2[k * 512 + n]; }
            else if (n < 1024) { if (k >= 64 && k < 128) v = a2[(k - 64) * 512 + (n - 512)]; }
            else { if (k >= 128) v = g2[(k - 128) * 512 + (n - 1024)]; }
            WB[WB_LR + idx] = (bf16_t)(pk_bf16(v, 0.f) & 0xffffu); }
    }
    if (l >= 1) {
        const float* v1 = p.in[21] + (size_t)(l - 1) * 512 * 32; const float* v2 = p.in[22] + (size_t)(l - 1) * 32 * 512;
        for (int idx = gt; idx < 512 * 512; idx += nth) { const int n = idx >> 9, k = idx & 511; float s = 0.f;
#pragma unroll 8
            for (int r = 0; r < 32; ++r) s += v1[k * 32 + r] * v2[r * 512 + n];
            WB[WB_V12 + idx] = (bf16_t)(pk_bf16(s, 0.f) & 0xffffu); }
    }
}
__device__ __forceinline__ void phase_cvt_x(const Params& p) {
    const float* x = p.in[0]; bf16_t* XB = (bf16_t*)(p.ws + WS_XB);
    const size_t n8 = (size_t)M_TOK * 1024 / 8, nth = (size_t)gridDim.x * 512;
    for (size_t i = (size_t)obid() * 512 + otid(); i < n8; i += 2 * nth) {
        const size_t i2 = i + nth; const bool h2 = i2 < n8;
        const f32x4 a = *(const f32x4*)(x + i * 8), b = *(const f32x4*)(x + i * 8 + 4);
        f32x4 c = a, d = b; if (h2) { c = *(const f32x4*)(x + i2 * 8); d = *(const f32x4*)(x + i2 * 8 + 4); }
        *(u32x4*)(XB + i * 8) = pack8(a, b);
        if (h2) *(u32x4*)(XB + i2 * 8) = pack8(c, d);
    }
}

__device__ __forceinline__ void phase_ln(const float* RES, const bf16_t* DEL, float* X, bf16_t* XB, const float* g, const float* b, bool write_xb) {
    const int tid = otid(), wid = tid >> 6, lane = tid & 63;
    const int nw = gridDim.x * 8, w0 = obid() * 8 + wid;
    for (int base = w0; base < M_TOK; base += nw * 4) {
        f32x4 v[4][4];
#pragma unroll
        for (int r = 0; r < 4; ++r) { const float* xr = RES + (size_t)(base + r * nw) * 1024; const bf16_t* dr = DEL + (size_t)(base + r * nw) * 1024;
#pragma unroll
            for (int i = 0; i < 2; ++i) { const int c = i * 512 + lane * 8; const f32x4 xa = *(const f32x4*)(xr + c), xb2 = *(const f32x4*)(xr + c + 4); const u32x4 d4 = *(const u32x4*)(dr + c);
                f32x4 da, db; unpack8(d4, da, db); v[r][2 * i] = xa * ALPHA + da; v[r][2 * i + 1] = xb2 * ALPHA + db; } }
        float mean[4], rs[4];
#pragma unroll
        for (int r = 0; r < 4; ++r) { float s = 0.f;
#pragma unroll
            for (int i = 0; i < 4; ++i) s += v[r][i][0] + v[r][i][1] + v[r][i][2] + v[r][i][3];
            mean[r] = wave_sum(s) * (1.f / 1024.f); }
#pragma unroll
        for (int r = 0; r < 4; ++r) { float q = 0.f;
#pragma unroll
            for (int i = 0; i < 4; ++i) { v[r][i] -= mean[r]; q += v[r][i][0] * v[r][i][0] + v[r][i][1] * v[r][i][1] + v[r][i][2] * v[r][i][2] + v[r][i][3] * v[r][i][3]; }
            rs[r] = rsqrtf(wave_sum(q) * (1.f / 1024.f) + 1e-5f); }
#pragma unroll
        for (int i = 0; i < 2; ++i) { const int c = i * 512 + lane * 8;
            const f32x4 ga = *(const f32x4*)(g + c), gb = *(const f32x4*)(g + c + 4), ba = *(const f32x4*)(b + c), bb = *(const f32x4*)(b + c + 4);
#pragma unroll
            for (int r = 0; r < 4; ++r) { const size_t ro = (size_t)(base + r * nw) * 1024 + c;
                const f32x4 oa = v[r][2 * i] * rs[r] * ga + ba, ob = v[r][2 * i + 1] * rs[r] * gb + bb;
                *(f32x4*)(X + ro) = oa; *(f32x4*)(X + ro + 4) = ob;
                if (write_xb) *(u32x4*)(XB + ro) = pack8(oa, ob); } }
    }
}

__device__ __forceinline__ void phase_prep(const Params& p, int l) {
    unsigned char* R = p.ws + WS_R;
    const bf16_t* U = (const bf16_t*)(R + R_U); bf16_t* Rb = (bf16_t*)(R + R_R); bf16_t* Kb = (bf16_t*)(R + R_K); bf16_t* Vb = (bf16_t*)(R + R_V); bf16_t* AP = (bf16_t*)(R + R_AP);
    bf16_t* VF = (bf16_t*)(p.ws + WS_VF);
    const float* mu = p.in[9] + (size_t)l * 1792;
    const int tid = otid(), wid = tid >> 6, lane = tid & 63;
    const bool has3 = lane < 32;
    f32x4 m0[4], m1[4];
#pragma unroll
    for (int i = 0; i < 4; ++i) { const int c = (i < 3 || has3) ? (lane + 64 * i) * 8 : 0; m0[i] = *(const f32x4*)(mu + c); m1[i] = *(const f32x4*)(mu + c + 4); }
    for (int wv = obid() * 8 + wid; wv < M_TOK / 16; wv += gridDim.x * 8) {
        const int row0 = wv * 16;
        u32x4 prv[4], cur[4];
#pragma unroll
        for (int i = 0; i < 4; ++i) { prv[i] = (u32x4){0u, 0u, 0u, 0u}; cur[i] = prv[i]; }
        if ((row0 & (SEQ - 1)) != 0) {
#pragma unroll
            for (int i = 0; i < 4; ++i) if (i < 3 || has3) prv[i] = *(const u32x4*)(U + (size_t)(row0 - 1) * 1792 + (lane + 64 * i) * 8);
        }
#pragma unroll
        for (int i = 0; i < 4; ++i) if (i < 3 || has3) cur[i] = *(const u32x4*)(U + (size_t)row0 * 1792 + (lane + 64 * i) * 8);
#pragma unroll 2
        for (int r = 0; r < 16; ++r) {
            const int row = row0 + r;
            u32x4 nxt[4];
#pragma unroll
            for (int i = 0; i < 4; ++i) { nxt[i] = (u32x4){0u, 0u, 0u, 0u}; if (r < 15 && (i < 3 || has3)) nxt[i] = *(const u32x4*)(U + (size_t)(row + 1) * 1792 + (lane + 64 * i) * 8); }
#pragma unroll
            for (int i = 0; i < 4; ++i) {
                f32x4 c0v, c1v, p0v, p1v; unpack8(cur[i], c0v, c1v); unpack8(prv[i], p0v, p1v);
                f32x4 u0 = c0v + (p0v - c0v) * m0[i], u1 = c1v + (p1v - c1v) * m1[i];
                if (i == 0) *(u32x4*)(Rb + (size_t)row * 512 + lane * 8) = pack8(u0, u1);
                else if (i == 1) *(u32x4*)(Kb + (size_t)row * 512 + lane * 8) = pack8(u0, u1);
                else if (i == 2) { const u32x4 w = pack8(u0, u1); *(u32x4*)(Vb + (size_t)row * 512 + lane * 8) = w; if (l == 0) *(u32x4*)(VF + (size_t)row * 512 + lane * 8) = w; }
                else if (has3) {
                    if (lane < 8) {
#pragma unroll
                        for (int j = 0; j < 4; ++j) { u0[j] = 1.f - 2.f * __builtin_amdgcn_rcpf(__expf(2.f * u0[j]) + 1.f); u1[j] = 1.f - 2.f * __builtin_amdgcn_rcpf(__expf(2.f * u1[j]) + 1.f); }
                    } else if (lane >= 16) { u0 = sigm4(u0); u1 = sigm4(u1); }
                    *(u32x4*)(AP + (size_t)row * 256 + lane * 8) = pack8(u0, u1);
                }
            }
#pragma unroll
            for (int i = 0; i < 4; ++i) { prv[i] = cur[i]; cur[i] = nxt[i]; }
        }
    }
}

__device__ __forceinline__ void lds_barrier() { asm volatile("s_waitcnt lgkmcnt(0)" ::: "memory"); __builtin_amdgcn_s_barrier(); asm volatile("" ::: "memory"); }
constexpr int SC_SLOT = 12288, SC_AT = 0, SC_RT = 2048, SC_BBT = 4096, SC_KBT = 6656, SC_AK = 9216, SC_X = 9728, SC_RB = 10240, SC_RK = 10752, SC_VP = 11264, SC_WC = 11776;
constexpr int SC_BS = 20;
constexpr int SC_NP = 5, SC_RING = 2 * SC_NP * SC_SLOT, SC_SCR = 6144;
__device__ __forceinline__ bf16x8 frag4(LAS const unsigned char* p) { const u32x2 w = *(LAS const u32x2*)p; return __builtin_bit_cast(bf16x8, (u32x4){w.x, w.y, 0u, 0u}); }
__device__ __forceinline__ bf16x8 cfrag(const f32x4 c) { return __builtin_bit_cast(bf16x8, (u32x4){pk_bf16(c[0], c[1]), pk_bf16(c[2], c[3]), 0u, 0u}); }
__device__ __forceinline__ bf16_t bf1(float x) { return (bf16_t)(pk_bf16(x, 0.f) & 0xffffu); }
__device__ __forceinline__ float wave_sum64(float x) { x = row16_sum(x); x += __shfl_xor(x, 16); x += __shfl_xor(x, 32); return x; }
__device__ __forceinline__ void st_mat(LAS unsigned char* rm, LAS unsigned char* tr, LAS unsigned char* trI, LAS unsigned char* rmI, const f32x4 c, int fr, int fq) {
#pragma unroll
    for (int r = 0; r < 4; ++r) { const int t = 4 * fq + r; const float v = c[r], vi = v + (t == fr ? 1.f : 0.f);
        if (rm) *(LAS bf16_t*)(rm + (t * 16 + fr) * 2) = bf1(v);
        if (tr) *(LAS bf16_t*)(tr + (fr * 16 + t) * 2) = bf1(v);
        if (trI) *(LAS bf16_t*)(trI + (fr * 16 + t) * 2) = bf1(vi);
        if (rmI) *(LAS bf16_t*)(rmI + (t * 16 + fr) * 2) = bf1(vi); }
}
__device__ __forceinline__ f32x4 mm16(LAS const unsigned char* Arm, LAS const unsigned char* Btr, int fr, int fq) {
    asm volatile("s_waitcnt lgkmcnt(0)" ::: "memory");
    const bf16x8 a = frag4(Arm + (fr * 16 + 4 * fq) * 2), b = frag4(Btr + (fr * 16 + 4 * fq) * 2);
    return __builtin_amdgcn_mfma_f32_16x16x32_bf16(a, b, (f32x4){0.f, 0.f, 0.f, 0.f}, 0, 0, 0);
}
__device__ __forceinline__ void phase_scan2(const Params& p, int l, LAS unsigned char* lds) {
    unsigned char* R = p.ws + WS_R;
    const bf16_t* Rb = (const bf16_t*)(R + R_R); const bf16_t* Kb = (const bf16_t*)(R + R_K); const bf16_t* Vb = (const bf16_t*)(R + (l == 0 ? R_V : R_VNEW));
    const bf16_t* Ab = (const bf16_t*)(R + R_A); const _Float16* EW = (const _Float16*)(R + R_EW);
    bf16_t* Y = (bf16_t*)(R + R_Y); float* CB = (float*)(R + R_CB);
    const float* k_k = p.in[15] + (size_t)l * 512; const float* k_a = p.in[16] + (size_t)l * 512; const float* r_k = p.in[17] + (size_t)l * 512;
    const int tid = otid(), wid = tid >> 6, lane = tid & 63, fr = lane & 15, fq = lane >> 4;
    constexpr int NCH = SEQ / 16, NRD = (NCH + SC_NP - 1) / SC_NP;
    for (int job = obid(); job < 256; job += gridDim.x) {
        const int bh = job >> 2, rg = job & 3, b = bh >> 3, h = bh & 7;
        const size_t tok0 = (size_t)b * SEQ;
        const int pw = wid - 3, j = lane;
        const float kkc = k_k[h * 64 + j], kac = k_a[h * 64 + j], rkc = r_k[h * 64 + j];
        unsigned short kraw[16], araw[16], rraw[16]; _Float16 eraw[16]; unsigned short vraw[4];
#pragma unroll
        for (int t = 0; t < 16; ++t) { kraw[t] = 0; araw[t] = 0; rraw[t] = 0; eraw[t] = (_Float16)0; }
#pragma unroll
        for (int q = 0; q < 4; ++q) vraw[q] = 0;
        auto pload = [&](int c) {
            const size_t base = (tok0 + (size_t)c * 16) * 512 + h * 64;
#pragma unroll
            for (int t = 0; t < 16; ++t) { const size_t off = base + (size_t)t * 512 + j; kraw[t] = Kb[off]; araw[t] = Ab[off]; rraw[t] = Rb[off]; eraw[t] = EW[off]; }
#pragma unroll
            for (int q = 0; q < 4; ++q) vraw[q] = Vb[base + (size_t)(4 * fq + q) * 512 + rg * 16 + fr];
        };
        auto pbuild = [&](int c, LAS unsigned char* sl, LAS unsigned char* sc, int cnext) {
            float W = 1.f;
            const int m = j >> 5, tp = (j >> 4) & 1, jw = j & 15, pidx = (jw >> 2) * 8 + tp * 4 + (jw & 3);
#pragma unroll
            for (int t = 0; t < 16; ++t) {
                const float k = bf2f(kraw[t]), a = bf2f(araw[t]), r = bf2f(rraw[t]);
                const float q = k * kkc, kp1 = k * (1.f + (a - 1.f) * kac);
                *(LAS bf16_t*)(sc + 0 + (t * 64 + j) * 2) = bf1(q * q);
                *(LAS bf16_t*)(sc + 2048 + (t * 64 + j) * 2) = bf1(r * kp1 * rkc);
            }
            asm volatile("s_waitcnt lgkmcnt(0)" ::: "memory");
            { const bf16x8 ones = __builtin_bit_cast(bf16x8, (u32x4){0x3F803F80u, 0x3F803F80u, 0x3F803F80u, 0x3F803F80u});
              f32x4 sq = (f32x4){0.f, 0.f, 0.f, 0.f}, sb = sq;
#pragma unroll
              for (int kk2 = 0; kk2 < 2; ++kk2) {
                  const bf16x8 fa = *(LAS const bf16x8*)(sc + 0 + (fr * 64 + kk2 * 32 + fq * 8) * 2), fu = *(LAS const bf16x8*)(sc + 2048 + (fr * 64 + kk2 * 32 + fq * 8) * 2);
                  sq = __builtin_amdgcn_mfma_f32_16x16x32_bf16(fa, ones, sq, 0, 0, 0); sb = __builtin_amdgcn_mfma_f32_16x16x32_bf16(fu, ones, sb, 0, 0, 0);
              }
              if (fr == 0) { *(LAS f32x4*)(sl + SC_X + fq * 16) = sq; *(LAS f32x4*)(sl + SC_X + 64 + fq * 16) = sb; }
              asm volatile("s_waitcnt lgkmcnt(0)" ::: "memory");
              if (rg == 0 && lane < 16) CB[(tok0 + (size_t)c * 16 + lane) * 8 + h] = *(LAS const float*)(sl + SC_X + 64 + lane * 4);
              asm volatile("s_waitcnt lgkmcnt(0)" ::: "memory");
            }
#pragma unroll
            for (int t = 0; t < 16; ++t) {
                const float k = bf2f(kraw[t]), a = bf2f(araw[t]), r = bf2f(rraw[t]), ew = (float)eraw[t];
                const float kk = k * kkc * rsqrtf(fmaxf(*(LAS const float*)(sl + SC_X + t * 4), 1e-24f));
                const float kp = k * (1.f + (a - 1.f) * kac);
                const float at = -kk * W;
                W *= __expf(-ew);
                const float rt = r * W, iw = __builtin_amdgcn_rcpf(W);
                const unsigned wbk = pk_bf16(kk * a * iw, kp * iw), war = pk_bf16(at, rt);
                const bf16_t bh = (bf16_t)(wbk & 0xffffu), kh = (bf16_t)(wbk >> 16), ah = (bf16_t)(war & 0xffffu), rh = (bf16_t)(war >> 16);
                *(LAS bf16_t*)(sl + SC_AT + ((m * 16 + t) * 32 + pidx) * 2) = ah;
                *(LAS bf16_t*)(sl + SC_RT + ((m * 16 + t) * 32 + pidx) * 2) = rh;
                *(LAS bf16_t*)(sl + SC_BBT + (j * SC_BS + t) * 2) = bh;
                *(LAS bf16_t*)(sl + SC_KBT + (j * SC_BS + t) * 2) = kh;
                *(LAS bf16_t*)(sc + 0 + ((m * 16 + t) * 32 + pidx) * 2) = bh;
                *(LAS bf16_t*)(sc + 2048 + ((m * 16 + t) * 32 + pidx) * 2) = kh;
            }
            *(LAS float*)(sl + SC_WC + j * 4) = W;
#pragma unroll
            for (int q = 0; q < 4; ++q) *(LAS bf16_t*)(sl + SC_VP + (fr * 16 + 4 * fq + q) * 2) = vraw[q];
            if (cnext >= 0) pload(cnext);
            asm volatile("s_waitcnt lgkmcnt(0)" ::: "memory");
            f32x4 AB = (f32x4){0.f, 0.f, 0.f, 0.f}, AKm = AB, RBm = AB, RKm = AB;
#pragma unroll
            for (int kk2 = 0; kk2 < 2; ++kk2) {
                const int fo = ((kk2 * 16 + fr) * 32 + fq * 8) * 2;
                const bf16x8 fa = *(LAS const bf16x8*)(sl + SC_AT + fo), fr_ = *(LAS const bf16x8*)(sl + SC_RT + fo);
                const bf16x8 fb = *(LAS const bf16x8*)(sc + 0 + fo), fk = *(LAS const bf16x8*)(sc + 2048 + fo);
                AB = __builtin_amdgcn_mfma_f32_16x16x32_bf16(fa, fb, AB, 0, 0, 0); AKm = __builtin_amdgcn_mfma_f32_16x16x32_bf16(fa, fk, AKm, 0, 0, 0);
                RBm = __builtin_amdgcn_mfma_f32_16x16x32_bf16(fr_, fb, RBm, 0, 0, 0); RKm = __builtin_amdgcn_mfma_f32_16x16x32_bf16(fr_, fk, RKm, 0, 0, 0);
            }
#pragma unroll
            for (int r = 0; r < 4; ++r) { const int t = 4 * fq + r; const bool lo = fr < t, le = fr <= t;
                AB[r] = lo ? AB[r] : 0.f; AKm[r] = lo ? AKm[r] : 0.f; RBm[r] = le ? RBm[r] : 0.f; RKm[r] = le ? RKm[r] : 0.f; }
            asm volatile("s_waitcnt lgkmcnt(0)" ::: "memory");
            st_mat(sl + SC_AK, nullptr, nullptr, nullptr, AKm, fr, fq);
            st_mat(sl + SC_RB, nullptr, nullptr, nullptr, RBm, fr, fq);
            st_mat(sl + SC_RK, nullptr, nullptr, nullptr, RKm, fr, fq);
            LAS unsigned char* mL = sc, *mLT = sc + 512, *mIL = sc + 1024, *mL2 = sc + 1536, *mL2T = sc + 2048, *mIL2T = sc + 2560, *mL4 = sc + 3072, *mL4T = sc + 3584, *mIL4T = sc + 4096, *mIL8T = sc + 4608, *mP1 = sc + 5120, *mP2 = sc + 5632;
            st_mat(mL, mLT, nullptr, mIL, AB, fr, fq);
            const f32x4 L2 = mm16(mL, mLT, fr, fq);      st_mat(mL2, mL2T, mIL2T, nullptr, L2, fr, fq);
            const f32x4 L4 = mm16(mL2, mL2T, fr, fq);    const f32x4 P1 = mm16(mIL, mIL2T, fr, fq);
            st_mat(mL4, mL4T, mIL4T, nullptr, L4, fr, fq); st_mat(mP1, nullptr, nullptr, nullptr, P1, fr, fq);
            const f32x4 L8 = mm16(mL4, mL4T, fr, fq);    const f32x4 P2 = mm16(mP1, mIL4T, fr, fq);
            st_mat(nullptr, nullptr, mIL8T, nullptr, L8, fr, fq); st_mat(mP2, nullptr, nullptr, nullptr, P2, fr, fq);
            const f32x4 X = mm16(mP2, mIL8T, fr, fq);    st_mat(sl + SC_X, nullptr, nullptr, nullptr, X, fr, fq);
            asm volatile("s_waitcnt lgkmcnt(0)" ::: "memory");
        };
        f32x4 ST[4];
#pragma unroll
        for (int jt = 0; jt < 4; ++jt) ST[jt] = (f32x4){0.f, 0.f, 0.f, 0.f};
        auto consume = [&](int c, LAS const unsigned char* sl) {
            const bf16x8 s0 = __builtin_bit_cast(bf16x8, (u32x4){pk_bf16(ST[0][0], ST[0][1]), pk_bf16(ST[0][2], ST[0][3]), pk_bf16(ST[1][0], ST[1][1]), pk_bf16(ST[1][2], ST[1][3])});
            const bf16x8 s1 = __builtin_bit_cast(bf16x8, (u32x4){pk_bf16(ST[2][0], ST[2][1]), pk_bf16(ST[2][2], ST[2][3]), pk_bf16(ST[3][0], ST[3][1]), pk_bf16(ST[3][2], ST[3][3])});
            const bf16x8 at0 = *(LAS const bf16x8*)(sl + SC_AT + (fr * 32 + fq * 8) * 2), at1 = *(LAS const bf16x8*)(sl + SC_AT + ((16 + fr) * 32 + fq * 8) * 2);
            const bf16x8 rt0 = *(LAS const bf16x8*)(sl + SC_RT + (fr * 32 + fq * 8) * 2), rt1 = *(LAS const bf16x8*)(sl + SC_RT + ((16 + fr) * 32 + fq * 8) * 2);
            const int mo = (fr * 16 + 4 * fq) * 2;
            const bf16x8 vf = frag4(sl + SC_VP + mo), akf = frag4(sl + SC_AK + mo), xf = frag4(sl + SC_X + mo), rbf = frag4(sl + SC_RB + mo), rkf = frag4(sl + SC_RK + mo);
            const f32x4 z = (f32x4){0.f, 0.f, 0.f, 0.f};
            f32x4 g = __builtin_amdgcn_mfma_f32_16x16x32_bf16(at0, s0, z, 0, 0, 0);
            g = __builtin_amdgcn_mfma_f32_16x16x32_bf16(at1, s1, g, 0, 0, 0);
            g = __builtin_amdgcn_mfma_f32_16x16x32_bf16(akf, vf, g, 0, 0, 0);
            const f32x4 sa = __builtin_amdgcn_mfma_f32_16x16x32_bf16(xf, cfrag(g), z, 0, 0, 0);
            const bf16x8 saf = cfrag(sa);
            f32x4 y = __builtin_amdgcn_mfma_f32_16x16x32_bf16(rt0, s0, z, 0, 0, 0);
            y = __builtin_amdgcn_mfma_f32_16x16x32_bf16(rt1, s1, y, 0, 0, 0);
            y = __builtin_amdgcn_mfma_f32_16x16x32_bf16(rbf, saf, y, 0, 0, 0);
            y = __builtin_amdgcn_mfma_f32_16x16x32_bf16(rkf, vf, y, 0, 0, 0);
#pragma unroll
            for (int jt = 0; jt < 4; ++jt) {
                const f32x4 wc = *(LAS const f32x4*)(sl + SC_WC + (16 * jt + 4 * fq) * 4);
                const bf16x8 bb = frag4(sl + SC_BBT + ((16 * jt + fr) * SC_BS + 4 * fq) * 2), kb = frag4(sl + SC_KBT + ((16 * jt + fr) * SC_BS + 4 * fq) * 2);
                f32x4 acc = ST[jt];
                acc = __builtin_amdgcn_mfma_f32_16x16x32_bf16(bb, saf, acc, 0, 0, 0);
                acc = __builtin_amdgcn_mfma_f32_16x16x32_bf16(kb, vf, acc, 0, 0, 0);
                ST[jt] = acc * wc;
            }
#pragma unroll
            for (int r = 0; r < 4; ++r) Y[(tok0 + (size_t)c * 16 + 4 * fq + r) * 512 + h * 64 + rg * 16 + fr] = bf1(y[r]);
        };
        LAS unsigned char* scr = lds + SC_RING + (pw < 0 ? 0 : pw) * SC_SCR;
        if (wid >= 3) { pload(pw); pbuild(pw, lds + pw * SC_SLOT, scr, SC_NP + pw); }
        lds_barrier();
        for (int rd = 0; rd < NRD; ++rd) {
            if (wid == 0) {
#pragma unroll 1
                for (int q = 0; q < SC_NP; ++q) { const int c = rd * SC_NP + q; if (c < NCH) consume(c, lds + ((rd & 1) * SC_NP + q) * SC_SLOT); }
            } else if (wid >= 3) {
                const int cb = (rd + 1) * SC_NP + pw, cn = cb + SC_NP;
                if (cb < NCH) pbuild(cb, lds + (((rd + 1) & 1) * SC_NP + pw) * SC_SLOT, scr, cn < NCH ? cn : -1);
            }
            lds_barrier();
        }
        __syncthreads();
    }
}

__device__ __forceinline__ void phase_attn(const Params& p, int l, LAS unsigned char* ldsb) {
    unsigned char* R = p.ws + WS_R;
    const bf16_t* QKV = (const bf16_t*)(R + R_QKV); bf16_t* ATT = (bf16_t*)(R + R_ATT);
    const float* relb = p.in[7]; const float* sinks = p.in[8] + l * 8;
    const int tid = otid(), wid = tid >> 6, lane = tid & 63, fr = lane & 15, fq = lane >> 4;
    LAS bf16_t* Ks = (LAS bf16_t*)ldsb;
    LAS bf16_t* Vt = (LAS bf16_t*)(ldsb + 36864);
    LAS float* biasL = (LAS float*)(ldsb + 70656);
    LAS bf16_t* Pw = (LAS bf16_t*)(ldsb + 72704) + wid * (16 * 168);
    for (int item = obid(); item < 512; item += gridDim.x) {
        const int g = item & 1, n = (item >> 1) & 31, b = item >> 6;
        const long tokc = (long)b * SEQ + n * 128, tokp = tokc - 128;
        {
            u32x4 vq[4], kq[4];
#pragma unroll
            for (int q = 0; q < 4; ++q) { const int idx = tid + 512 * q, key = idx >> 3, d8 = idx & 7; vq[q] = (u32x4){0u, 0u, 0u, 0u}; kq[q] = vq[q];
                if (n > 0 || key >= 128) { const bf16_t* src = QKV + (size_t)(tokp + key) * 768 + 512 + g * 64 + d8 * 8; kq[q] = *(const u32x4*)src; vq[q] = *(const u32x4*)(src + 128); } }
#pragma unroll
            for (int q = 0; q < 4; ++q) { const int idx = tid + 512 * q, key = idx >> 3, d8 = idx & 7; const u32x4 v = vq[q];
                *(LAS u32x4*)(Ks + key * 72 + d8 * 8) = kq[q];
#pragma unroll
                for (int e = 0; e < 8; ++e) Vt[(d8 * 8 + e) * 264 + key] = (bf16_t)((e & 1) ? (v[e >> 1] >> 16) : (v[e >> 1] & 0xffffu)); }
        }
        { const int hl = tid >> 7, d = tid & 127; int bk = d;
          if (d >= 16) { bk = 16 + (int)(__logf((float)d * 0.0625f) * (16.f / 2.07944154168f)); bk = bk > 31 ? 31 : bk; }
          biasL[tid] = relb[bk * 8 + g * 4 + hl]; }
        __syncthreads();
        const int hl = wid >> 1, hq = g * 4 + hl; const float sink = sinks[hq];
        for (int rt = 0; rt < 4; ++rt) {
            const int q0 = (wid & 1) * 64 + rt * 16, kstart = q0 < 96 ? q0 : 96;
            bf16x8 qa0, qa1; { const bf16_t* qp = QKV + (size_t)(tokc + q0 + fr) * 768 + hq * 64 + fq * 8; qa0 = *(const bf16x8*)qp; qa1 = *(const bf16x8*)(qp + 32); }
            f32x4 S[10];
#pragma unroll
            for (int kt = 0; kt < 10; ++kt) {
                LAS const bf16_t* kp = Ks + (kstart + kt * 16 + fr) * 72 + fq * 8;
                const bf16x8 k0 = *(LAS const bf16x8*)kp, k1 = *(LAS const bf16x8*)(kp + 32);
                f32x4 z = (f32x4){0.f, 0.f, 0.f, 0.f};
                z = __builtin_amdgcn_mfma_f32_16x16x32_bf16(qa0, k0, z, 0, 0, 0);
                z = __builtin_amdgcn_mfma_f32_16x16x32_bf16(qa1, k1, z, 0, 0, 0);
                S[kt] = z;
            }
            float mx[4] = {-INFINITY, -INFINITY, -INFINITY, -INFINITY};
#pragma unroll
            for (int kt = 0; kt < 10; ++kt)
#pragma unroll
                for (int j = 0; j < 4; ++j) {
                    const int key = kstart + kt * 16 + fr, dist = q0 + 4 * fq + j + 128 - key;
                    const bool ok = (dist >= 0) && (dist < 128) && (n > 0 || key >= 128);
                    const float s = ok ? (S[kt][j] * 0.125f + biasL[hl * 128 + (dist & 127)]) : -INFINITY;
                    S[kt][j] = s; mx[j] = fmaxf(mx[j], s);
                }
            float inv[4];
#pragma unroll
            for (int j = 0; j < 4; ++j) mx[j] = fmaxf(row16_max(mx[j]), sink);
            float sm[4] = {0.f, 0.f, 0.f, 0.f};
#pragma unroll
            for (int kt = 0; kt < 10; ++kt)
#pragma unroll
                for (int j = 0; j < 4; ++j) { const float e = __expf(S[kt][j] - mx[j]); S[kt][j] = e; sm[j] += e; }
#pragma unroll
            for (int j = 0; j < 4; ++j) inv[j] = 1.f / (row16_sum(sm[j]) + __expf(sink - mx[j]));
#pragma unroll
            for (int kt = 0; kt < 10; ++kt)
#pragma unroll
                for (int j = 0; j < 4; ++j) Pw[(4 * fq + j) * 168 + kt * 16 + fr] = (bf16_t)(pk_bf16(S[kt][j] * inv[j], 0.f) & 0xffffu);
            asm volatile("s_waitcnt lgkmcnt(0)" ::: "memory");
            __builtin_amdgcn_wave_barrier();
            f32x4 O[4];
#pragma unroll
            for (int dt = 0; dt < 4; ++dt) O[dt] = (f32x4){0.f, 0.f, 0.f, 0.f};
#pragma unroll
            for (int kk = 0; kk < 5; ++kk) {
                const bf16x8 pa = *(LAS const bf16x8*)(Pw + fr * 168 + kk * 32 + fq * 8);
#pragma unroll
                for (int dt = 0; dt < 4; ++dt) {
                    const bf16x8 vb = *(LAS const bf16x8*)(Vt + (dt * 16 + fr) * 264 + kstart + kk * 32 + fq * 8);
                    O[dt] = __builtin_amdgcn_mfma_f32_16x16x32_bf16(pa, vb, O[dt], 0, 0, 0);
                }
            }
#pragma unroll
            for (int dt = 0; dt < 4; ++dt)
#pragma unroll
                for (int j = 0; j < 4; ++j) ATT[(size_t)(tokc + q0 + 4 * fq + j) * 512 + hq * 64 + dt * 16 + fr] = (bf16_t)(pk_bf16(O[dt][j], 0.f) & 0xffffu);
            asm volatile("s_waitcnt lgkmcnt(0)" ::: "memory");
            __builtin_amdgcn_wave_barrier();
        }
        __syncthreads();
    }
}

__device__ __forceinline__ void phase_post(const Params& p, int l) {
    unsigned char* R = p.ws + WS_R;
    bf16_t* Y = (bf16_t*)(R + R_Y); const bf16_t* Vb = (const bf16_t*)(R + (l == 0 ? R_V : R_VNEW)); const bf16_t* G = (const bf16_t*)(R + R_G); const float* CB = (const float*)(R + R_CB);
    const float* gng = p.in[18] + (size_t)l * 512; const float* gnb = p.in[19] + (size_t)l * 512;
    const size_t total = (size_t)M_TOK * 64, nth = (size_t)gridDim.x * 512;
    const size_t it0 = (size_t)obid() * 512 + otid();
    const int c0 = (int)(it0 & 63) * 8, h = c0 >> 6;
    const f32x4 gg0 = *(const f32x4*)(gng + c0), gg1 = *(const f32x4*)(gng + c0 + 4), gb0 = *(const f32x4*)(gnb + c0), gb1 = *(const f32x4*)(gnb + c0 + 4);
    for (size_t it = it0; it < total; it += 2 * nth) {
        u32x4 yw[2], vw[2], gw[2]; float cb[2]; size_t row[2]; bool ok[2];
#pragma unroll
        for (int u = 0; u < 2; ++u) { const size_t iu = it + u * nth; ok[u] = iu < total; row[u] = (ok[u] ? iu : it) >> 6;
            yw[u] = *(const u32x4*)(Y + row[u] * 512 + c0); vw[u] = *(const u32x4*)(Vb + row[u] * 512 + c0); gw[u] = *(const u32x4*)(G + row[u] * 512 + c0); cb[u] = CB[row[u] * 8 + h]; }
#pragma unroll
        for (int u = 0; u < 2; ++u) {
            f32x4 y0, y1; unpack8(yw[u], y0, y1);
            float s = y0[0] + y0[1] + y0[2] + y0[3] + y1[0] + y1[1] + y1[2] + y1[3];
            s += dpp_f<0xB1>(s); s += dpp_f<0x4E>(s); s += dpp_f<0x141>(s);
            const float mu = s * (1.f / 64.f);
            y0 -= mu; y1 -= mu;
            float q = y0[0] * y0[0] + y0[1] * y0[1] + y0[2] * y0[2] + y0[3] * y0[3] + y1[0] * y1[0] + y1[1] * y1[1] + y1[2] * y1[2] + y1[3] * y1[3];
            q += dpp_f<0xB1>(q); q += dpp_f<0x4E>(q); q += dpp_f<0x141>(q);
            const float rs = rsqrtf(q * (1.f / 64.f) + 64e-5f);
            f32x4 v0, v1, g0, g1; unpack8(vw[u], v0, v1); unpack8(gw[u], g0, g1);
            const f32x4 o0 = (y0 * rs * gg0 + gb0 + v0 * cb[u]) * g0, o1 = (y1 * rs * gg1 + gb1 + v1 * cb[u]) * g1;
            if (ok[u]) *(u32x4*)(Y + row[u] * 512 + c0) = pack8(o0, o1);
        }
    }
}


#define XB_TMO      128
#define XB_XCNT(j)  (256  + 64 * (j))
#define XB_XSUB(j)  (1280 + 64 * (j))
#define XB_XGEN(j)  (2304 + 64 * (j))
#define XB_TOP      3328
#define XB_TOPGEN   3392
#define XCD_BAR_WORDS 3456
#define XB_SPIN_CAP (1u << 20)
__device__ __forceinline__ unsigned xb_ld(unsigned* p)              { return __hip_atomic_load(p, __ATOMIC_RELAXED, __HIP_MEMORY_SCOPE_AGENT); }
__device__ __forceinline__ unsigned xb_add(unsigned* p, unsigned v) { return __hip_atomic_fetch_add(p, v, __ATOMIC_RELAXED, __HIP_MEMORY_SCOPE_AGENT); }
__device__ __forceinline__ unsigned xb_xcc_id() { return (unsigned)__builtin_amdgcn_s_getreg((3 << 11) | 20) & 0xFu; }
#define XB_SPIN(cond, bar) do { unsigned _sp = 0; while (cond) { __builtin_amdgcn_s_sleep(1); \
    if ((++_sp & 255u) == 0u) { if (xb_ld(&(bar)[XB_TMO])) break; if (_sp > XB_SPIN_CAP) { atomicAdd(&(bar)[XB_TMO], 1u); break; } } } } while (0)
struct XcdBarrier { unsigned* bar; unsigned x; volatile LAS unsigned* st; };
__device__ __forceinline__ XcdBarrier xcd_barrier_post(unsigned* bar, volatile LAS unsigned* st) {
    XcdBarrier b; b.bar = bar; b.x = xb_xcc_id(); b.st = st;
    if (threadIdx.x == 0) (void)xb_add(&bar[XB_XCNT(b.x)], 1u);
    return b;
}
__device__ __forceinline__ void xcd_barrier_complete(unsigned* bar, unsigned x, unsigned& nloc, unsigned& nx) {
    const unsigned G = gridDim.x * gridDim.y * gridDim.z;
    unsigned sum, cnt, mine, sp = 0u;
    for (;;) {
        sum = 0u; cnt = 0u; mine = 0u;
#pragma unroll
        for (unsigned j = 0; j < 16; ++j) { const unsigned c = xb_ld(&bar[XB_XCNT(j)]); sum += c; cnt += (c > 0u) ? 1u : 0u; mine = (j == x) ? c : mine; }
        if (sum == G) break;
        __builtin_amdgcn_s_sleep(1);
        if ((++sp & 255u) == 0u) { if (xb_ld(&bar[XB_TMO])) break; if (sp > XB_SPIN_CAP) { atomicAdd(&bar[XB_TMO], 1u); break; } }
    }
    nloc = mine > 0u ? mine : 1u; nx = cnt > 0u ? cnt : 1u;
}
__device__ __forceinline__ void xcd_barrier(const XcdBarrier& b) {
    asm volatile("s_waitcnt vmcnt(0)" ::: "memory");
    __syncthreads();
    if (threadIdx.x == 0) {
        unsigned* bar = b.bar;
        __builtin_amdgcn_s_waitcnt(0);
        unsigned nloc = b.st[0], nx = b.st[1];
        if (nloc == 0u) { xcd_barrier_complete(bar, b.x, nloc, nx); b.st[0] = nloc; b.st[1] = nx; }
        const unsigned old = xb_add(&bar[XB_XSUB(b.x)], 1u);
        const unsigned gen = old / nloc;
        if (old + 1u == (gen + 1u) * nloc) {
            __builtin_amdgcn_fence(__ATOMIC_RELEASE, "agent");
            asm volatile("s_waitcnt vmcnt(0)" ::: "memory");
            const unsigned og = xb_add(&bar[XB_TOP], 1u);
            const unsigned tg = og / nx;
            if (og + 1u == (tg + 1u) * nx) xb_add(&bar[XB_TOPGEN], 1u);
            else XB_SPIN(xb_ld(&bar[XB_TOPGEN]) == tg, bar);
            __builtin_amdgcn_fence(__ATOMIC_ACQUIRE, "agent");
            xb_add(&bar[XB_XGEN(b.x)], 1u);
            asm volatile("s_waitcnt vmcnt(0)" ::: "memory");
        } else {
            XB_SPIN(xb_ld(&bar[XB_XGEN(b.x)]) == gen, bar);
            __builtin_amdgcn_fence(__ATOMIC_ACQUIRE, "agent");
            asm volatile("s_waitcnt vmcnt(0)" ::: "memory");
        }
    }
    __syncthreads();
}

__device__ __forceinline__ void gsync(cg::grid_group& grid) {
    asm volatile("s_waitcnt vmcnt(0) lgkmcnt(0)" ::: "memory");
    grid.sync();
    __builtin_amdgcn_fence(__ATOMIC_ACQUIRE, "agent");
    asm volatile("s_waitcnt vmcnt(0)" ::: "memory");
}
__global__ void __launch_bounds__(512, 2) fwd_kernel(Params p) {
    extern __shared__ __attribute__((aligned(16))) unsigned char shm[];
    LAS unsigned char* lds = (LAS unsigned char*)shm;
    cg::grid_group grid = cg::this_grid();
    unsigned char* R = p.ws + WS_R;
    const bf16_t* WB = (const bf16_t*)(p.ws + WS_WB);
    bf16_t* XB = (bf16_t*)(p.ws + WS_XB);

    volatile LAS unsigned* xst = (volatile LAS unsigned*)(lds + LDS_XB);
    if (threadIdx.x == 0) { xst[0] = 0u; xst[1] = 0u; }
    __syncthreads();
    const XcdBarrier xb = xcd_barrier_post((unsigned*)(p.ws + WS_BAR), xst);
    phase_cvt_x(p);
    phase_wprep(p, 0, (LAS float*)lds);
    gsync(grid);
#pragma unroll 1
    for (int hs = 0; hs < 4; ++hs) {
        const int l = hs >> 1, j = hs & 1;
        { Gemm g; g.A = XB; g.Bt = WB + (j ? WB_GU1 : WB_GU0); g.M = M_TOK; g.N = 5632; g.K = 1024;
          EpiGU e; e.H = (bf16_t*)(R + R_HB); gemm_phase(lds, g, e); }
        xcd_barrier(xb);
        { Gemm g; g.A = (const bf16_t*)(R + R_HB); g.Bt = WB + (j ? WB_D1 : WB_D0); g.M = M_TOK; g.N = 1024; g.K = 2816;
          EpiP<FDelta> e; e.f.D = (bf16_t*)(R + R_DEL); e.f.beta = 0.5f; gemm_phase(lds, g, e); }
        xcd_barrier(xb);
        { const int li = l * 3 + (j ? 2 : 0); phase_ln((hs == 0) ? p.in[0] : p.out, (const bf16_t*)(R + R_DEL), p.out, XB, p.in[3] + (size_t)li * 1024, p.in[4] + (size_t)li * 1024, hs != 3); }
        if (hs == 1) phase_wprep(p, 1, (LAS float*)lds);
        xcd_barrier(xb);
        if (j == 0) {
            { Gemm g; g.A = XB; g.Bt = WB + WB_IN + (size_t)2048 * 1024; g.M = M_TOK; g.N = 2560; g.K = 1024;
              EpiP<FProj> e; e.f.QKV = (bf16_t*)(R + R_QKV); e.f.U = (bf16_t*)(R + R_U); e.f.bias = p.in[6] + (size_t)l * 4608 + 2048; gemm_phase(lds, g, e); }
            xcd_barrier(xb);
            phase_prep(p, l);
            xcd_barrier(xb);
            { Gemm g; g.A = (const bf16_t*)(R + R_AP); g.Bt = WB + WB_LR; g.M = M_TOK; g.N = 1536; g.K = 256;
              EpiP<FLowRank> e; e.f.EW = (_Float16*)(R + R_EW); e.f.A = (bf16_t*)(R + R_A); e.f.G = (bf16_t*)(R + R_G); e.f.w0 = p.in[10] + (size_t)l * 512; e.f.a0 = p.in[12] + (size_t)l * 512;
              gemm_phase(lds, g, e); }
            if (l >= 1) {
                Gemm g; g.A = (const bf16_t*)(R + R_V); g.Bt = WB + WB_V12; g.M = M_TOK; g.N = 512; g.K = 512;
                EpiP<FVmix> e; e.f.V = (const bf16_t*)(R + R_V); e.f.VF = (const bf16_t*)(p.ws + WS_VF); e.f.VN = (bf16_t*)(R + R_VNEW); e.f.v0p = p.in[20] + (size_t)(l - 1) * 512;
                gemm_phase(lds, g, e);
            }
            xcd_barrier(xb);
            phase_scan2(p, l, lds);
            phase_attn(p, l, lds);
            xcd_barrier(xb);
            phase_post(p, l);
            { Gemm g; g.A = XB; g.Bt = WB + WB_IN; g.M = M_TOK; g.N = 2048; g.K = 1024;
              EpiP<FGates> e; e.f.GA = (bf16_t*)(R + R_GA); e.f.GB = (bf16_t*)(R + R_GB); e.f.bias = p.in[6] + (size_t)l * 4608; gemm_phase(lds, g, e); }
            xcd_barrier(xb);
            { Gemm g; g.A = (const bf16_t*)(R + R_ATT); g.Bt = WB + WB_BA; g.M = M_TOK; g.N = 1024; g.K = 512;
              EpiP<FBranch<false>> e; e.f.GT = (const bf16_t*)(R + R_GA); e.f.MB = (bf16_t*)(R + R_MB); gemm_phase(lds, g, e); }
            asm volatile("s_waitcnt vmcnt(0)" ::: "memory");
            { Gemm g; g.A = (const bf16_t*)(R + R_Y); g.Bt = WB + WB_BB; g.M = M_TOK; g.N = 1024; g.K = 512;
              EpiP<FBranch<true>> e; e.f.GT = (const bf16_t*)(R + R_GB); e.f.MB = (bf16_t*)(R + R_MB); gemm_phase(lds, g, e); }
            xcd_barrier(xb);
            { Gemm g; g.A = (const bf16_t*)(R + R_MB); g.Bt = WB + WB_O; g.M = M_TOK; g.N = 1024; g.K = 1024;
              EpiP<FDelta> e; e.f.D = (bf16_t*)(R + R_DEL); e.f.beta = 1.0f; gemm_phase(lds, g, e); }
            xcd_barrier(xb);
            { const int li = l * 3 + 1; phase_ln(p.out, (const bf16_t*)(R + R_DEL), p.out, XB, p.in[3] + (size_t)li * 1024, p.in[4] + (size_t)li * 1024, true); }
            xcd_barrier(xb);
        }
    }
}

extern "C" void kernel_launch(void* const* d_in, const int* in_sizes, int n_in, void* d_out, int out_size, void* d_ws, size_t ws_size, hipStream_t stream) {
    static int grid = 0;
    if (grid == 0) {
        if (n_in != 26 || ws_size < WS_END) { grid = -1; return; }
        int dev = 0, cus = 0, per_cu = 0;
        (void)hipGetDevice(&dev);
        (void)hipDeviceGetAttribute(&cus, hipDeviceAttributeMultiprocessorCount, dev);
        (void)hipFuncSetAttribute((const void*)fwd_kernel, hipFuncAttributeMaxDynamicSharedMemorySize, LDS_BYTES);
        if (hipOccupancyMaxActiveBlocksPerMultiprocessor(&per_cu, (const void*)fwd_kernel, 512, LDS_BYTES) != hipSuccess || per_cu < 1) per_cu = 1;
        (void)hipGetLastError();
        grid = cus * 1;
        if (grid <= 0) grid = 256;
    }
    if (grid < 0) return;
    (void)hipMemsetAsync((unsigned char*)d_ws + WS_BAR, 0, XCD_BAR_WORDS * sizeof(unsigned), stream);
    Params p{};
    for (int i = 0; i < 26; ++i) p.in[i] = (const float*)d_in[i];
    p.out = (float*)d_out; p.ws = (unsigned char*)d_ws;
    void* args[] = {&p};
    (void)hipLaunchCooperativeKernel((const void*)fwd_kernel, dim3(grid), dim3(512), args, LDS_BYTES, stream);
}
```

```cpp
#include <hip/hip_runtime.h>
#include <hip/hip_cooperative_groups.h>
#include <math.h>
namespace cg = cooperative_groups;

#define LAS __attribute__((address_space(3)))
typedef unsigned short bf16_t;
typedef short bf16x8 __attribute__((ext_vector_type(8)));
typedef float f32x4 __attribute__((ext_vector_type(4)));
typedef unsigned u32x4 __attribute__((ext_vector_type(4)));
typedef unsigned u32x2 __attribute__((ext_vector_type(2)));

constexpr int M_TOK = 32768, SEQ = 4096;
constexpr float ALPHA = 1.41421356237f;
constexpr int LDS_XB = 153600;
constexpr int LDS_BYTES = LDS_XB + 16;

constexpr size_t MiB = 1u << 20;
constexpr size_t WS_WB = 0, WS_XB = 48 * MiB, WS_VF = 112 * MiB, WS_R = 144 * MiB, WS_END = 512 * MiB, WS_BAR = 47 * MiB + 512 * 1024;
constexpr size_t R_HB = 0, R_QKV = 0, R_U = 48 * MiB, R_VNEW = 48 * MiB, R_Y = 80 * MiB, R_ATT = 112 * MiB, R_CB = 144 * MiB,
                 R_R = 160 * MiB, R_K = 192 * MiB, R_V = 224 * MiB, R_AP = 256 * MiB, R_EW = 272 * MiB, R_A = 304 * MiB, R_G = 336 * MiB,
                 R_DEL = 176 * MiB, R_GA = 160 * MiB, R_GB = 256 * MiB, R_MB = 0;
constexpr size_t WB_GU0 = 0, WB_GU1 = 5767168, WB_D0 = 11534336, WB_D1 = 14417920, WB_IN = 17301504, WB_BA = 22020096, WB_BB = 22544384,
                 WB_O = 23068672, WB_LR = 24117248, WB_V12 = 24510464;

struct Params {
    const float* in[26];
    float* out;
    unsigned char* ws;
};

typedef __bf16 bf16x2_t __attribute__((ext_vector_type(2)));
typedef float f32x2_t __attribute__((ext_vector_type(2)));
__device__ __forceinline__ unsigned pk_bf16(float lo, float hi) { const f32x2_t f = {lo, hi}; return __builtin_bit_cast(unsigned, __builtin_convertvector(f, bf16x2_t)); }
__device__ __forceinline__ float bf_lo(unsigned w) { return __uint_as_float(w << 16); }
__device__ __forceinline__ float bf_hi(unsigned w) { return __uint_as_float(w & 0xffff0000u); }
__device__ __forceinline__ float bf2f(bf16_t b) { return __uint_as_float(((unsigned)b) << 16); }
__device__ __forceinline__ float sigm(float x) { return __builtin_amdgcn_rcpf(1.f + __expf(-x)); }
__device__ __forceinline__ int otid() { int t = threadIdx.x; asm volatile("" : "+v"(t)); return t; }
__device__ __forceinline__ int obid() { int b = blockIdx.x; asm volatile("" : "+s"(b)); return b; }
__device__ __forceinline__ float wave_sum(float x);
template <int CTRL> __device__ __forceinline__ float dpp_f(float x) { return __builtin_bit_cast(float, __builtin_amdgcn_mov_dpp(__builtin_bit_cast(int, x), CTRL, 0xF, 0xF, true)); }
__device__ __forceinline__ float row16_sum(float x) {
    x += dpp_f<0xB1>(x); x += dpp_f<0x4E>(x); x += dpp_f<0x141>(x); x += dpp_f<0x140>(x); return x;
}
__device__ __forceinline__ float row16_max(float x) {
    x = fmaxf(x, dpp_f<0xB1>(x)); x = fmaxf(x, dpp_f<0x4E>(x)); x = fmaxf(x, dpp_f<0x141>(x)); x = fmaxf(x, dpp_f<0x140>(x)); return x;
}
__device__ __forceinline__ float wave_sum(float x) {
    x = row16_sum(x);
    const int xi = __builtin_bit_cast(int, x);
    const float a = __builtin_bit_cast(float, __builtin_amdgcn_readlane(xi, 0)), b = __builtin_bit_cast(float, __builtin_amdgcn_readlane(xi, 16)),
                c = __builtin_bit_cast(float, __builtin_amdgcn_readlane(xi, 32)), d = __builtin_bit_cast(float, __builtin_amdgcn_readlane(xi, 48));
    return (a + b) + (c + d);
}

constexpr int BM = 256, BK = 64, HALF = 128, HTB = HALF * BK * 2, NXCD = 8, WGM = 8;
__device__ __forceinline__ int lds_byte(int r, int c) { const int st = (r >> 4) * 2 + (c >> 5), rr = r & 15, cc = c & 31, ob = rr * 64 + cc * 2; return st * 1024 + (ob ^ (((ob >> 9) & 1) << 5)); }
__device__ __forceinline__ void stage_rc(int b, int& R, int& C) { const int st = b / 1024, sb = b % 1024, swz = sb ^ (((sb >> 9) & 1) << 5); R = (st >> 1) * 16 + swz / 64; C = (st & 1) * 32 + (swz % 64) / 2; }
__device__ __forceinline__ int perm32(int rho) { const int n = rho >> 4, i = rho & 15; return 8 * (i >> 2) + 4 * n + (i & 3); }

struct Unit { int pm, pn; };
struct Gemm { const bf16_t* A; const bf16_t* Bt; int M, N, K; };
struct StaticOrder {
    int nM, nN, nwg, G, c;
    __device__ void init(int M, int N, int G_, int c_) { nM = M / BM; nN = N / BM; nwg = nM * nN; G = G_; c = c_; }
    __device__ bool next(int i, Unit& u) const {
        const long L = (long)i * G + c; if (L >= nwg) return false;
        int wgid = (int)L; { const int q = nwg / NXCD, r = nwg % NXCD, xcd = wgid % NXCD, off = wgid / NXCD; wgid = (xcd < r ? xcd * (q + 1) : r * (q + 1) + (xcd - r) * q) + off; }
        const int nig = WGM * nN, gid = wgid / nig, fm = gid * WGM, gsz = (nM - fm) < WGM ? (nM - fm) : WGM;
        u.pm = fm + ((wgid % nig) % gsz); u.pn = (wgid % nig) / gsz; return true;
    }
};

template <class Epi>
__device__ __forceinline__ void gemm_phase(LAS unsigned char* lds, const Gemm g, const Epi& E) {
    const int tid = otid(), wid = __builtin_amdgcn_readfirstlane(tid >> 6), lane = tid & 63, wr = wid >> 2, wc = wid & 3, fr = lane & 15, fq = lane >> 4;
    int Kop = g.K; asm volatile("" : "+s"(Kop));
    const int K = Kop, nt = K / BK;
    StaticOrder S; S.init(g.M, g.N, (int)gridDim.x, obid());
    unsigned voffA[2], voffB[2];
#pragma unroll
    for (int i = 0; i < 2; ++i) { int R, C; stage_rc(tid * 16 + i * 8192, R, C); const int Rb = Epi::PERM ? ((R & ~31) + perm32(R & 31)) : R;
        voffA[i] = (unsigned)(R * K + C) * 2u; voffB[i] = (unsigned)(Rb * K + C) * 2u; }
    const size_t kstep = (size_t)(BK * 2);
    const size_t hstep = (size_t)HALF * K * 2;
    const size_t tstep = 2 * hstep;
    const unsigned ldsw = (unsigned)wid * 1024u;
    const int aoff = lds_byte(wr * 64 + fr, fq * 8), boff = lds_byte(wc * 32 + fr, fq * 8);
#define PG8_SA(b, h) (((b) * 2 + (h)) * HTB)
#define PG8_SB(b, h) ((4 + (b) * 2 + (h)) * HTB)
#define PG8_STAGE(bufoff, gbase, voff) do { _Pragma("unroll") for (int _i = 0; _i < 2; ++_i) \
        __builtin_amdgcn_global_load_lds((const unsigned*)((const char*)(gbase) + (voff)[_i]), (LAS unsigned*)(lds + (bufoff) + ldsw + _i * 8192), 16, 0, 0); } while (0)
#define PG8_LDA(dst, b, h) do { _Pragma("unroll") for (int m = 0; m < 4; ++m) _Pragma("unroll") for (int k = 0; k < 2; ++k) dst[m][k] = *(const LAS bf16x8*)(lds + PG8_SA(b, h) + aoff + m * 2048 + k * 1024); } while (0)
#define PG8_LDB(dst, b, h) do { _Pragma("unroll") for (int n = 0; n < 2; ++n) _Pragma("unroll") for (int k = 0; k < 2; ++k) dst[n][k] = *(const LAS bf16x8*)(lds + PG8_SB(b, h) + boff + n * 2048 + k * 1024); } while (0)
#define PG8_MMA(ai, bj, At, Bt) do { __builtin_amdgcn_s_setprio(1); _Pragma("unroll") for (int m = 0; m < 4; ++m) _Pragma("unroll") for (int n = 0; n < 2; ++n) _Pragma("unroll") for (int k = 0; k < 2; ++k) \
        acc[ai][bj][m][n] = __builtin_amdgcn_mfma_f32_16x16x32_bf16(Bt[n][k], At[m][k], acc[ai][bj][m][n], 0, 0, 0); __builtin_amdgcn_s_setprio(0); } while (0)
#define PG8_WAIT_V(n) asm volatile("s_waitcnt vmcnt(" #n ")" ::: "memory")
#define PG8_WAIT_L(n) asm volatile("s_waitcnt lgkmcnt(" #n ")" ::: "memory")
#define PG8_BAR __builtin_amdgcn_s_barrier()
#define PG8_SCHED __builtin_amdgcn_sched_barrier(0)
    Unit cur, nxt; int ui = 0;
    if (!S.next(0, cur)) return;
    f32x4 acc[2][2][4][2];
#pragma unroll
    for (int a = 0; a < 2; ++a)
#pragma unroll
        for (int b = 0; b < 2; ++b)
#pragma unroll
            for (int m = 0; m < 4; ++m)
#pragma unroll
                for (int n = 0; n < 2; ++n) acc[a][b][m][n] = (f32x4){0.f, 0.f, 0.f, 0.f};
    bf16x8 At[4][2], B0[2][2], B1[2][2];
    const char* cA = (const char*)g.A + (size_t)cur.pm * tstep; const char* cB = (const char*)g.Bt + (size_t)cur.pn * tstep;
    PG8_STAGE(PG8_SB(0, 0), cB, voffB); PG8_STAGE(PG8_SA(0, 0), cA, voffA); PG8_STAGE(PG8_SB(0, 1), cB + hstep, voffB); PG8_STAGE(PG8_SA(0, 1), cA + hstep, voffA);
    if (wr == 1) PG8_BAR;
    PG8_WAIT_V(4); PG8_BAR;
    PG8_STAGE(PG8_SB(1, 0), cB + kstep, voffB); PG8_STAGE(PG8_SA(1, 0), cA + kstep, voffA); PG8_STAGE(PG8_SB(1, 1), cB + hstep + kstep, voffB);
    PG8_WAIT_V(6); PG8_BAR;
    for (;;) {
        const bool has_next = S.next(ui + 1, nxt);
        const char* nA = has_next ? (const char*)g.A + (size_t)nxt.pm * tstep : cA; const char* nB = has_next ? (const char*)g.Bt + (size_t)nxt.pn * tstep : cB;
#pragma unroll 1
        for (int t = 0; t < nt; t += 2) {
            const bool last = (t == nt - 2);
            const char* a1 = cA + (size_t)(t + 1) * kstep;
            const char* a2 = last ? nA : cA + (size_t)(t + 2) * kstep; const char* b2 = last ? nB : cB + (size_t)(t + 2) * kstep;
            const char* a3 = a2 + kstep; const char* b3 = b2 + kstep;
            PG8_LDB(B0, 0, 0); PG8_SCHED; PG8_LDA(At, 0, 0); PG8_STAGE(PG8_SA(1, 1), a1 + hstep, voffA);
            PG8_WAIT_L(8); PG8_BAR; PG8_WAIT_L(0); PG8_MMA(0, 0, At, B0); PG8_BAR; PG8_SCHED;
            PG8_LDB(B1, 0, 1); PG8_STAGE(PG8_SB(0, 0), b2, voffB);
            PG8_BAR; PG8_WAIT_L(0); PG8_MMA(0, 1, At, B1); PG8_BAR;
            PG8_LDA(At, 0, 1); PG8_STAGE(PG8_SA(0, 0), a2, voffA);
            PG8_BAR; PG8_WAIT_L(0); PG8_MMA(1, 0, At, B0); PG8_BAR; PG8_SCHED;
            PG8_STAGE(PG8_SB(0, 1), b2 + hstep, voffB);
            PG8_WAIT_V(6); PG8_BAR; PG8_MMA(1, 1, At, B1); PG8_BAR;
            PG8_LDB(B0, 1, 0); PG8_SCHED; PG8_LDA(At, 1, 0); PG8_STAGE(PG8_SA(0, 1), a2 + hstep, voffA);
            PG8_WAIT_L(8); PG8_BAR; PG8_WAIT_L(0); PG8_MMA(0, 0, At, B0); PG8_BAR; PG8_SCHED;
            PG8_LDB(B1, 1, 1); PG8_STAGE(PG8_SB(1, 0), b3, voffB);
            PG8_BAR; PG8_WAIT_L(0); PG8_MMA(0, 1, At, B1); PG8_BAR;
            PG8_LDA(At, 1, 1); PG8_STAGE(PG8_SA(1, 0), a3, voffA);
            PG8_BAR; PG8_WAIT_L(0); PG8_MMA(1, 0, At, B0); PG8_BAR; PG8_SCHED;
            PG8_STAGE(PG8_SB(1, 1), b3 + hstep, voffB);
            PG8_WAIT_V(6); PG8_BAR; PG8_MMA(1, 1, At, B1); PG8_BAR;
        }
        { int fr2 = fr, fq2 = fq; asm volatile("" : "+v"(fr2), "+v"(fq2)); E(acc, cur, wr, wc, fr2, fq2); }
        if (!has_next) break;
#pragma unroll
        for (int a = 0; a < 2; ++a)
#pragma unroll
            for (int b = 0; b < 2; ++b)
#pragma unroll
                for (int m = 0; m < 4; ++m)
#pragma unroll
                    for (int n = 0; n < 2; ++n) acc[a][b][m][n] = (f32x4){0.f, 0.f, 0.f, 0.f};
        cur = nxt; cA = nA; cB = nB; ++ui;
    }
    PG8_WAIT_V(0);
    if (wr == 0) PG8_BAR;
    PG8_BAR;
#undef PG8_SA
#undef PG8_SB
#undef PG8_STAGE
#undef PG8_LDA
#undef PG8_LDB
#undef PG8_MMA
#undef PG8_WAIT_V
#undef PG8_WAIT_L
#undef PG8_BAR
#undef PG8_SCHED
}

struct EpiGU {
    static constexpr bool PERM = false;
    bf16_t* H;
    __device__ __forceinline__ void operator()(const f32x4 (&acc)[2][2][4][2], const Unit& u, int wr, int wc, int fr, int fq) const {
        const int row0 = u.pm * BM + wr * 64 + fr, col0 = u.pn * 128 + wc * 32 + fq * 8;
#pragma unroll
        for (int ai = 0; ai < 2; ++ai)
#pragma unroll
            for (int m = 0; m < 4; ++m) {
                float h[8];
#pragma unroll
                for (int bj = 0; bj < 2; ++bj)
#pragma unroll
                    for (int j = 0; j < 4; ++j) { const float gt = acc[ai][bj][m][0][j], up = acc[ai][bj][m][1][j]; h[bj * 4 + j] = gt * sigm(gt) * up; }
                u32x4 w; w.x = pk_bf16(h[0], h[1]); w.y = pk_bf16(h[2], h[3]); w.z = pk_bf16(h[4], h[5]); w.w = pk_bf16(h[6], h[7]);
                *(u32x4*)(H + (size_t)(row0 + ai * HALF + m * 16) * 2816 + col0) = w;
            }
    }
};
struct EpiRes {
    static constexpr bool PERM = false;
    const float* res; float* out; float alpha, beta;
    __device__ __forceinline__ void operator()(const f32x4 (&acc)[2][2][4][2], const Unit& u, int wr, int wc, int fr, int fq) const {
        const int row0 = u.pm * BM + wr * 64 + fr, col0 = u.pn * BM + wc * 32 + 4 * fq;
#pragma unroll
        for (int ai = 0; ai < 2; ++ai)
#pragma unroll
            for (int mp = 0; mp < 2; ++mp) {
                f32x4 x[2][2][2];
#pragma unroll
                for (int mm = 0; mm < 2; ++mm)
#pragma unroll
                    for (int bj = 0; bj < 2; ++bj)
#pragma unroll
                        for (int n = 0; n < 2; ++n) x[mm][bj][n] = *(const f32x4*)(res + (size_t)(row0 + ai * HALF + (mp * 2 + mm) * 16) * 1024 + col0 + bj * HALF + n * 16);
#pragma unroll
                for (int mm = 0; mm < 2; ++mm)
#pragma unroll
                    for (int bj = 0; bj < 2; ++bj)
#pragma unroll
                        for (int n = 0; n < 2; ++n) *(f32x4*)(out + (size_t)(row0 + ai * HALF + (mp * 2 + mm) * 16) * 1024 + col0 + bj * HALF + n * 16) = x[mm][bj][n] * alpha + acc[ai][bj][mp * 2 + mm][n] * beta;
            }
    }
};
template <class F> struct EpiP {
    static constexpr bool PERM = true;
    F f;
    __device__ __forceinline__ void operator()(const f32x4 (&acc)[2][2][4][2], const Unit& u, int wr, int wc, int fr, int fq) const {
        const int row0 = u.pm * BM + wr * 64 + fr, cb0 = u.pn * BM + wc * 32 + 8 * fq;
        typename F::Col cv[2];
#pragma unroll
        for (int bj = 0; bj < 2; ++bj) cv[bj] = f.col(cb0 + bj * HALF, u.pn);
#pragma unroll
        for (int ai = 0; ai < 2; ++ai)
#pragma unroll
          for (int mp = 0; mp < 2; ++mp) {
            typename F::Pos pv[2][2];
#pragma unroll
            for (int mm = 0; mm < 2; ++mm)
#pragma unroll
                for (int bj = 0; bj < 2; ++bj) pv[mm][bj] = f.pos(row0 + ai * HALF + (mp * 2 + mm) * 16, cb0 + bj * HALF, u.pn);
#pragma unroll
            for (int mm = 0; mm < 2; ++mm)
#pragma unroll
                for (int bj = 0; bj < 2; ++bj) f.fin(row0 + ai * HALF + (mp * 2 + mm) * 16, cb0 + bj * HALF, acc[ai][bj][mp * 2 + mm][0], acc[ai][bj][mp * 2 + mm][1], u.pn, cv[bj], pv[mm][bj]);
          }
    }
};
struct Col8 { f32x4 a, b; };
struct None {};
__device__ __forceinline__ u32x4 pack8(const f32x4 a, const f32x4 b) { u32x4 w; w.x = pk_bf16(a[0], a[1]); w.y = pk_bf16(a[2], a[3]); w.z = pk_bf16(b[0], b[1]); w.w = pk_bf16(b[2], b[3]); return w; }
__device__ __forceinline__ void unpack8(const u32x4 w, f32x4& a, f32x4& b) { a[0] = bf_lo(w.x); a[1] = bf_hi(w.x); a[2] = bf_lo(w.y); a[3] = bf_hi(w.y); b[0] = bf_lo(w.z); b[1] = bf_hi(w.z); b[2] = bf_lo(w.w); b[3] = bf_hi(w.w); }
__device__ __forceinline__ f32x4 sigm4(const f32x4 x) { f32x4 r; r[0] = sigm(x[0]); r[1] = sigm(x[1]); r[2] = sigm(x[2]); r[3] = sigm(x[3]); return r; }

struct FProj {
    typedef Col8 Col; typedef None Pos;
    bf16_t* QKV; bf16_t* U; const float* bias;
    __device__ __forceinline__ Col col(int cb, int) const { Col c; c.a = *(const f32x4*)(bias + cb); c.b = *(const f32x4*)(bias + cb + 4); return c; }
    __device__ __forceinline__ Pos pos(int, int, int) const { return None{}; }
    __device__ __forceinline__ void fin(int row, int cb, f32x4 v0, f32x4 v1, int pn, const Col& c, const Pos&) const {
        bf16_t* dst = (pn < 3) ? (QKV + (size_t)row * 768 + cb) : (U + (size_t)row * 1792 + (cb - 768));
        *(u32x4*)dst = pack8(v0 + c.a, v1 + c.b);
    }
};
struct FLowRank {
    typedef Col8 Col; typedef None Pos;
    _Float16* EW; bf16_t* A; bf16_t* G; const float* w0; const float* a0;
    __device__ __forceinline__ Col col(int cb, int pn) const { Col c; const float* src = (pn < 2) ? (w0 + cb) : (a0 + ((cb - 512) & 511)); c.a = *(const f32x4*)src; c.b = *(const f32x4*)(src + 4); return c; }
    __device__ __forceinline__ Pos pos(int, int, int) const { return None{}; }
    __device__ __forceinline__ void fin(int row, int cb, f32x4 v0, f32x4 v1, int pn, const Col& c, const Pos&) const {
        if (pn < 2) {
            v0 = sigm4(v0 + c.a) * 0.60653065971f; v1 = sigm4(v1 + c.b) * 0.60653065971f;
            typedef _Float16 h8 __attribute__((ext_vector_type(8)));
            h8 o; o[0] = (_Float16)v0[0]; o[1] = (_Float16)v0[1]; o[2] = (_Float16)v0[2]; o[3] = (_Float16)v0[3]; o[4] = (_Float16)v1[0]; o[5] = (_Float16)v1[1]; o[6] = (_Float16)v1[2]; o[7] = (_Float16)v1[3];
            *(h8*)(EW + (size_t)row * 512 + cb) = o;
        } else if (pn < 4) {
            *(u32x4*)(A + (size_t)row * 512 + (cb - 512)) = pack8(sigm4(v0 + c.a), sigm4(v1 + c.b));
        } else {
            *(u32x4*)(G + (size_t)row * 512 + (cb - 1024)) = pack8(v0, v1);
        }
    }
};
struct FDelta {
    typedef None Col; typedef None Pos;
    bf16_t* D; float beta;
    __device__ __forceinline__ Col col(int, int) const { return None{}; }
    __device__ __forceinline__ Pos pos(int, int, int) const { return None{}; }
    __device__ __forceinline__ void fin(int row, int cb, f32x4 v0, f32x4 v1, int, const Col&, const Pos&) const {
        *(u32x4*)(D + (size_t)row * 1024 + cb) = pack8(v0 * beta, v1 * beta);
    }
};
struct Pos2 { u32x4 a, b; };
struct FVmix {
    typedef Col8 Col; typedef Pos2 Pos;
    const bf16_t* V; const bf16_t* VF; bf16_t* VN; const float* v0p;
    __device__ __forceinline__ Col col(int cb, int) const { Col c; c.a = *(const f32x4*)(v0p + cb); c.b = *(const f32x4*)(v0p + cb + 4); return c; }
    __device__ __forceinline__ Pos pos(int row, int cb, int) const { Pos q; q.a = *(const u32x4*)(V + (size_t)row * 512 + cb); q.b = *(const u32x4*)(VF + (size_t)row * 512 + cb); return q; }
    __device__ __forceinline__ void fin(int row, int cb, f32x4 v0, f32x4 v1, int, const Col& c, const Pos& q) const {
        const f32x4 s0 = sigm4(v0 + c.a), s1 = sigm4(v1 + c.b);
        f32x4 a0, a1, f0, f1; unpack8(q.a, a0, a1); unpack8(q.b, f0, f1);
        *(u32x4*)(VN + (size_t)row * 512 + cb) = pack8(a0 + (f0 - a0) * s0, a1 + (f1 - a1) * s1);
    }
};
struct FGates {
    typedef Col8 Col; typedef None Pos;
    bf16_t* GA; bf16_t* GB; const float* bias;
    __device__ __forceinline__ Col col(int cb, int) const { Col c; c.a = *(const f32x4*)(bias + cb); c.b = *(const f32x4*)(bias + cb + 4); return c; }
    __device__ __forceinline__ Pos pos(int, int, int) const { return None{}; }
    __device__ __forceinline__ void fin(int row, int cb, f32x4 v0, f32x4 v1, int pn, const Col& c, const Pos&) const {
        bf16_t* dst = (pn < 4) ? (GA + (size_t)row * 1024 + cb) : (GB + (size_t)row * 1024 + (cb - 1024));
        *(u32x4*)dst = pack8(sigm4(v0 + c.a), sigm4(v1 + c.b));
    }
};
template <bool ADD> struct FBranch {
    typedef None Col; typedef Pos2 Pos;
    const bf16_t* GT; bf16_t* MB;
    __device__ __forceinline__ Col col(int, int) const { return None{}; }
    __device__ __forceinline__ Pos pos(int row, int cb, int) const { Pos q; q.a = *(const u32x4*)(GT + (size_t)row * 1024 + cb); q.b = ADD ? *(const u32x4*)(MB + (size_t)row * 1024 + cb) : (u32x4){0u, 0u, 0u, 0u}; return q; }
    __device__ __forceinline__ void fin(int row, int cb, f32x4 v0, f32x4 v1, int, const Col&, const Pos& q) const {
        f32x4 g0, g1; unpack8(q.a, g0, g1);
        f32x4 r0 = g0 * v0, r1 = g1 * v1;
        if (ADD) { f32x4 m0, m1; unpack8(q.b, m0, m1); r0 += m0; r1 += m1; }
        *(u32x4*)(MB + (size_t)row * 1024 + cb) = pack8(r0, r1);
    }
};

__device__ __forceinline__ int gu_row(int c) {
    const int nn = c >= 2816 ? 1 : 0, hc = c - 2816 * nn, pn = hc >> 7, rem = hc & 127, wc = rem >> 5, r5 = rem & 31, ih = r5 >> 3, bj = (r5 >> 2) & 1, il = r5 & 3;
    return 256 * pn + bj * 128 + wc * 32 + nn * 16 + ih * 4 + il;
}
__device__ __forceinline__ void wtrans(const float* __restrict__ src, int K, int N, bf16_t* __restrict__ dst, int ldd, int mode, LAS float* tile) {
    const int tid = otid(), tn = N >> 6, nt = (K >> 6) * tn;
    for (int t = obid(); t < nt; t += gridDim.x) {
        const int k0 = (t / tn) << 6, c0 = (t % tn) << 6;
        {
#pragma unroll
          for (int i = 0; i < 2; ++i) { const int e = tid + 512 * i, kl = e >> 4, c4 = (e & 15) * 4;
              const f32x4 v4 = *(const f32x4*)(src + (size_t)(k0 + kl) * N + c0 + c4);
              tile[kl * 65 + c4] = v4[0]; tile[kl * 65 + c4 + 1] = v4[1]; tile[kl * 65 + c4 + 2] = v4[2]; tile[kl * 65 + c4 + 3] = v4[3]; } }
        __syncthreads();
        { const int kp = tid & 31, cl0 = tid >> 5;
#pragma unroll
          for (int i = 0; i < 4; ++i) { const int cl = cl0 + 16 * i, c = c0 + cl; const int R = mode ? gu_row(c) : c;
              *(unsigned*)(dst + (size_t)R * ldd + k0 + 2 * kp) = pk_bf16(tile[(2 * kp) * 65 + cl], tile[(2 * kp + 1) * 65 + cl]); } }
        __syncthreads();
    }
}
__device__ __forceinline__ void phase_wprep(const Params& p, int l, LAS float* tile) {
    bf16_t* WB = (bf16_t*)(p.ws + WS_WB);
    wtrans(p.in[1] + (size_t)(l * 2 + 0) * 1024 * 5632, 1024, 5632, WB + WB_GU0, 1024, 1, tile);
    wtrans(p.in[1] + (size_t)(l * 2 + 1) * 1024 * 5632, 1024, 5632, WB + WB_GU1, 1024, 1, tile);
    wtrans(p.in[2] + (size_t)(l * 2 + 0) * 2816 * 1024, 2816, 1024, WB + WB_D0, 2816, 0, tile);
    wtrans(p.in[2] + (size_t)(l * 2 + 1) * 2816 * 1024, 2816, 1024, WB + WB_D1, 2816, 0, tile);
    wtrans(p.in[5] + (size_t)l * 1024 * 4608, 1024, 4608, WB + WB_IN, 1024, 0, tile);
    wtrans(p.in[23] + (size_t)l * 512 * 1024, 512, 1024, WB + WB_BA, 512, 0, tile);
    wtrans(p.in[24] + (size_t)l * 512 * 1024, 512, 1024, WB + WB_BB, 512, 0, tile);
    wtrans(p.in[25] + (size_t)l * 1024 * 1024, 1024, 1024, WB + WB_O, 1024, 0, tile);
    const int gt = obid() * 512 + otid(), nth = gridDim.x * 512;
    {
        const float* w2 = p.in[11] + (size_t)l * 64 * 512; const float* a2 = p.in[13] + (size_t)l * 64 * 512; const float* g2 = p.in[14] + (size_t)l * 128 * 512;
        for (int idx = gt; idx < 1536 * 256; idx += nth) { const int n = idx >> 8, k = idx & 255; float v = 0.f;
            if (n < 512) { if (k < 64) v = w2[k * 512 + n]; }
            else if (n < 1024) { if (k >= 64 && k < 128) v = a2[(k - 64) * 512 + (n - 512)]; }
            else { if (k >= 128) v = g2[(k - 128) * 512 + (n - 1024)]; }
            WB[WB_LR + idx] = (bf16_t)(pk_bf16(v, 0.f) & 0xffffu); }
    }
    if (l >= 1) {
        const float* v1 = p.in[21] + (size_t)(l - 1) * 512 * 32; const float* v2 = p.in[22] + (size_t)(l - 1) * 32 * 512;
        for (int idx = gt; idx < 512 * 512; idx += nth) { const int n = idx >> 9, k = idx & 511; float s = 0.f;
#pragma unroll 8
            for (int r = 0; r < 32; ++r) s += v1[k * 32 + r] * v2[r * 512 + n];
            WB[WB_V12 + idx] = (bf16_t)(pk_bf16(s, 0.f) & 0xffffu); }
    }
}
__device__ __forceinline__ void phase_cvt_x(const Params& p) {
    const float* x = p.in[0]; bf16_t* XB = (bf16_t*)(p.ws + WS_XB);
    const size_t n8 = (size_t)M_TOK * 1024 / 8, nth = (size_t)gridDim.x * 512;
    for (size_t i = (size_t)obid() * 512 + otid(); i < n8; i += 2 * nth) {
        const size_t i2 = i + nth; const bool h2 = i2 < n8;
        const f32x4 a = *(const f32x4*)(x + i * 8), b = *(const f32x4*)(x + i * 8 + 4);
        f32x4 c = a, d = b; if (h2) { c = *(const f32x4*)(x + i2 * 8); d = *(const f32x4*)(x + i2 * 8 + 4); }
        *(u32x4*)(XB + i * 8) = pack8(a, b);
        if (h2) *(u32x4*)(XB + i2 * 8) = pack8(c, d);
    }
}

__device__ __forceinline__ void phase_ln(const float* RES, const bf16_t* DEL, float* X, bf16_t* XB, const float* g, const float* b, bool write_xb) {
    const int tid = otid(), wid = tid >> 6, lane = tid & 63;
    const int nw = gridDim.x * 8, w0 = obid() * 8 + wid;
    for (int base = w0; base < M_TOK; base += nw * 4) {
        f32x4 v[4][4];
#pragma unroll
        for (int r = 0; r < 4; ++r) { const float* xr = RES + (size_t)(base + r * nw) * 1024; const bf16_t* dr = DEL + (size_t)(base + r * nw) * 1024;
#pragma unroll
            for (int i = 0; i < 2; ++i) { const int c = i * 512 + lane * 8; const f32x4 xa = *(const f32x4*)(xr + c), xb2 = *(const f32x4*)(xr + c + 4); const u32x4 d4 = *(const u32x4*)(dr + c);
                f32x4 da, db; unpack8(d4, da, db); v[r][2 * i] = xa * ALPHA + da; v[r][2 * i + 1] = xb2 * ALPHA + db; } }
        float mean[4], rs[4];
#pragma unroll
        for (int r = 0; r < 4; ++r) { float s = 0.f;
#pragma unroll
            for (int i = 0; i < 4; ++i) s += v[r][i][0] + v[r][i][1] + v[r][i][2] + v[r][i][3];
            mean[r] = wave_sum(s) * (1.f / 1024.f); }
#pragma unroll
        for (int r = 0; r < 4; ++r) { float q = 0.f;
#pragma unroll
            for (int i = 0; i < 4; ++i) { v[r][i] -= mean[r]; q += v[r][i][0] * v[r][i][0] + v[r][i][1] * v[r][i][1] + v[r][i][2] * v[r][i][2] + v[r][i][3] * v[r][i][3]; }
            rs[r] = rsqrtf(wave_sum(q) * (1.f / 1024.f) + 1e-5f); }
#pragma unroll
        for (int i = 0; i < 2; ++i) { const int c = i * 512 + lane * 8;
            const f32x4 ga = *(const f32x4*)(g + c), gb = *(const f32x4*)(g + c + 4), ba = *(const f32x4*)(b + c), bb = *(const f32x4*)(b + c + 4);
#pragma unroll
            for (int r = 0; r < 4; ++r) { const size_t ro = (size_t)(base + r * nw) * 1024 + c;
                const f32x4 oa = v[r][2 * i] * rs[r] * ga + ba, ob = v[r][2 * i + 1] * rs[r] * gb + bb;
                *(f32x4*)(X + ro) = oa; *(f32x4*)(X + ro + 4) = ob;
                if (write_xb) *(u32x4*)(XB + ro) = pack8(oa, ob); } }
    }
}

__device__ __forceinline__ void phase_prep(const Params& p, int l) {
    unsigned char* R = p.ws + WS_R;
    const bf16_t* U = (const bf16_t*)(R + R_U); bf16_t* Rb = (bf16_t*)(R + R_R); bf16_t* Kb = (bf16_t*)(R + R_K); bf16_t* Vb = (bf16_t*)(R + R_V); bf16_t* AP = (bf16_t*)(R + R_AP);
    bf16_t* VF = (bf16_t*)(p.ws + WS_VF);
    const float* mu = p.in[9] + (size_t)l * 1792;
    const int tid = otid(), wid = tid >> 6, lane = tid & 63;
    const bool has3 = lane < 32;
    f32x4 m0[4], m1[4];
#pragma unroll
    for (int i = 0; i < 4; ++i) { const int c = (i < 3 || has3) ? (lane + 64 * i) * 8 : 0; m0[i] = *(const f32x4*)(mu + c); m1[i] = *(const f32x4*)(mu + c + 4); }
    for (int wv = obid() * 8 + wid; wv < M_TOK / 16; wv += gridDim.x * 8) {
        const int row0 = wv * 16;
        u32x4 prv[4], cur[4];
#pragma unroll
        for (int i = 0; i < 4; ++i) { prv[i] = (u32x4){0u, 0u, 0u, 0u}; cur[i] = prv[i]; }
        if ((row0 & (SEQ - 1)) != 0) {
#pragma unroll
            for (int i = 0; i < 4; ++i) if (i < 3 || has3) prv[i] = *(const u32x4*)(U + (size_t)(row0 - 1) * 1792 + (lane + 64 * i) * 8);
        }
#pragma unroll
        for (int i = 0; i < 4; ++i) if (i < 3 || has3) cur[i] = *(const u32x4*)(U + (size_t)row0 * 1792 + (lane + 64 * i) * 8);
#pragma unroll 2
        for (int r = 0; r < 16; ++r) {
            const int row = row0 + r;
            u32x4 nxt[4];
#pragma unroll
            for (int i = 0; i < 4; ++i) { nxt[i] = (u32x4){0u, 0u, 0u, 0u}; if (r < 15 && (i < 3 || has3)) nxt[i] = *(const u32x4*)(U + (size_t)(row + 1) * 1792 + (lane + 64 * i) * 8); }
#pragma unroll
            for (int i = 0; i < 4; ++i) {
                f32x4 c0v, c1v, p0v, p1v; unpack8(cur[i], c0v, c1v); unpack8(prv[i], p0v, p1v);
                f32x4 u0 = c0v + (p0v - c0v) * m0[i], u1 = c1v + (p1v - c1v) * m1[i];
                if (i == 0) *(u32x4*)(Rb + (size_t)row * 512 + lane * 8) = pack8(u0, u1);
                else if (i == 1) *(u32x4*)(Kb + (size_t)row * 512 + lane * 8) = pack8(u0, u1);
                else if (i == 2) { const u32x4 w = pack8(u0, u1); *(u32x4*)(Vb + (size_t)row * 512 + lane * 8) = w; if (l == 0) *(u32x4*)(VF + (size_t)row * 512 + lane * 8) = w; }
                else if (has3) {
                    if (lane < 8) {
#pragma unroll
                        for (int j = 0; j < 4; ++j) { u0[j] = 1.f - 2.f * __builtin_amdgcn_rcpf(__expf(2.f * u0[j]) + 1.f); u1[j] = 1.f - 2.f * __builtin_amdgcn_rcpf(__expf(2.f * u1[j]) + 1.f); }
                    } else if (lane >= 16) { u0 = sigm4(u0); u1 = sigm4(u1); }
                    *(u32x4*)(AP + (size_t)row * 256 + lane * 8) = pack8(u0, u1);
                }
            }
#pragma unroll
            for (int i = 0; i < 4; ++i) { prv[i] = cur[i]; cur[i] = nxt[i]; }
        }
    }
}

__device__ __forceinline__ void lds_barrier() { asm volatile("s_waitcnt lgkmcnt(0)" ::: "memory"); __builtin_amdgcn_s_barrier(); asm volatile("" ::: "memory"); }
constexpr int SC_SLOT = 12288, SC_AT = 0, SC_RT = 2048, SC_BBT = 4096, SC_KBT = 6656, SC_AK = 9216, SC_X = 9728, SC_RB = 10240, SC_RK = 10752, SC_VP = 11264, SC_WC = 11776;
constexpr int SC_BS = 20;
constexpr int SC_NP = 5, SC_RING = 2 * SC_NP * SC_SLOT, SC_SCR = 6144;
__device__ __forceinline__ bf16x8 frag4(LAS const unsigned char* p) { const u32x2 w = *(LAS const u32x2*)p; return __builtin_bit_cast(bf16x8, (u32x4){w.x, w.y, 0u, 0u}); }
__device__ __forceinline__ bf16x8 cfrag(const f32x4 c) { return __builtin_bit_cast(bf16x8, (u32x4){pk_bf16(c[0], c[1]), pk_bf16(c[2], c[3]), 0u, 0u}); }
__device__ __forceinline__ bf16_t bf1(float x) { return (bf16_t)(pk_bf16(x, 0.f) & 0xffffu); }
__device__ __forceinline__ float wave_sum64(float x) { x = row16_sum(x); x += __shfl_xor(x, 16); x += __shfl_xor(x, 32); return x; }
__device__ __forceinline__ void st_mat(LAS unsigned char* rm, LAS unsigned char* tr, LAS unsigned char* trI, LAS unsigned char* rmI, const f32x4 c, int fr, int fq) {
#pragma unroll
    for (int r = 0; r < 4; ++r) { const int t = 4 * fq + r; const float v = c[r], vi = v + (t == fr ? 1.f : 0.f);
        if (rm) *(LAS bf16_t*)(rm + (t * 16 + fr) * 2) = bf1(v);
        if (tr) *(LAS bf16_t*)(tr + (fr * 16 + t) * 2) = bf1(v);
        if (trI) *(LAS bf16_t*)(trI + (fr * 16 + t) * 2) = bf1(vi);
        if (rmI) *(LAS bf16_t*)(rmI + (t * 16 + fr) * 2) = bf1(vi); }
}
__device__ __forceinline__ f32x4 mm16(LAS const unsigned char* Arm, LAS const unsigned char* Btr, int fr, int fq) {
    asm volatile("s_waitcnt lgkmcnt(0)" ::: "memory");
    const bf16x8 a = frag4(Arm + (fr * 16 + 4 * fq) * 2), b = frag4(Btr + (fr * 16 + 4 * fq) * 2);
    return __builtin_amdgcn_mfma_f32_16x16x32_bf16(a, b, (f32x4){0.f, 0.f, 0.f, 0.f}, 0, 0, 0);
}
__device__ __forceinline__ void phase_scan2(const Params& p, int l, LAS unsigned char* lds) {
    unsigned char* R = p.ws + WS_R;
    const bf16_t* Rb = (const bf16_t*)(R + R_R); const bf16_t* Kb = (const bf16_t*)(R + R_K); const bf16_t* Vb = (const bf16_t*)(R + (l == 0 ? R_V : R_VNEW));
    const bf16_t* Ab = (const bf16_t*)(R + R_A); const _Float16* EW = (const _Float16*)(R + R_EW);
    bf16_t* Y = (bf16_t*)(R + R_Y); float* CB = (float*)(R + R_CB);
    const float* k_k = p.in[15] + (size_t)l * 512; const float* k_a = p.in[16] + (size_t)l * 512; const float* r_k = p.in[17] + (size_t)l * 512;
    const int tid = otid(), wid = tid >> 6, lane = tid & 63, fr = lane & 15, fq = lane >> 4;
    constexpr int NCH = SEQ / 16, NRD = (NCH + SC_NP - 1) / SC_NP;
    for (int job = obid(); job < 256; job += gridDim.x) {
        const int bh = job >> 2, rg = job & 3, b = bh >> 3, h = bh & 7;
        const size_t tok0 = (size_t)b * SEQ;
        const int pw = wid - 3, j = lane;
        const float kkc = k_k[h * 64 + j], kac = k_a[h * 64 + j], rkc = r_k[h * 64 + j];
        unsigned short kraw[16], araw[16], rraw[16]; _Float16 eraw[16]; unsigned short vraw[4];
#pragma unroll
        for (int t = 0; t < 16; ++t) { kraw[t] = 0; araw[t] = 0; rraw[t] = 0; eraw[t] = (_Float16)0; }
#pragma unroll
        for (int q = 0; q < 4; ++q) vraw[q] = 0;
        auto pload = [&](int c) {
            const size_t base = (tok0 + (size_t)c * 16) * 512 + h * 64;
#pragma unroll
            for (int t = 0; t < 16; ++t) { const size_t off = base + (size_t)t * 512 + j; kraw[t] = Kb[off]; araw[t] = Ab[off]; rraw[t] = Rb[off]; eraw[t] = EW[off]; }
#pragma unroll
            for (int q = 0; q < 4; ++q) vraw[q] = Vb[base + (size_t)(4 * fq + q) * 512 + rg * 16 + fr];
        };
        auto pbuild = [&](int c, LAS unsigned char* sl, LAS unsigned char* sc, int cnext) {
            float W = 1.f;
            const int m = j >> 5, tp = (j >> 4) & 1, jw = j & 15, pidx = (jw >> 2) * 8 + tp * 4 + (jw & 3);
#pragma unroll
            for (int t = 0; t < 16; ++t) {
                const float k = bf2f(kraw[t]), a = bf2f(araw[t]), r = bf2f(rraw[t]);
                const float q = k * kkc, kp1 = k * (1.f + (a - 1.f) * kac);
                *(LAS bf16_t*)(sc + 0 + (t * 64 + j) * 2) = bf1(q * q);
                *(LAS bf16_t*)(sc + 2048 + (t * 64 + j) * 2) = bf1(r * kp1 * rkc);
            }
            asm volatile("s_waitcnt lgkmcnt(0)" ::: "memory");
            { const bf16x8 ones = __builtin_bit_cast(bf16x8, (u32x4){0x3F803F80u, 0x3F803F80u, 0x3F803F80u, 0x3F803F80u});
              f32x4 sq = (f32x4){0.f, 0.f, 0.f, 0.f}, sb = sq;
#pragma unroll
              for (int kk2 = 0; kk2 < 2; ++kk2) {
                  const bf16x8 fa = *(LAS const bf16x8*)(sc + 0 + (fr * 64 + kk2 * 32 + fq * 8) * 2), fu = *(LAS const bf16x8*)(sc + 2048 + (fr * 64 + kk2 * 32 + fq * 8) * 2);
                  sq = __builtin_amdgcn_mfma_f32_16x16x32_bf16(fa, ones, sq, 0, 0, 0); sb = __builtin_amdgcn_mfma_f32_16x16x32_bf16(fu, ones, sb, 0, 0, 0);
              }
              if (fr == 0) { *(LAS f32x4*)(sl + SC_X + fq * 16) = sq; *(LAS f32x4*)(sl + SC_X + 64 + fq * 16) = sb; }
              asm volatile("s_waitcnt lgkmcnt(0)" ::: "memory");
              if (rg == 0 && lane < 16) CB[(tok0 + (size_t)c * 16 + lane) * 8 + h] = *(LAS const float*)(sl + SC_X + 64 + lane * 4);
              asm volatile("s_waitcnt lgkmcnt(0)" ::: "memory");
            }
#pragma unroll
            for (int t = 0; t < 16; ++t) {
                const float k = bf2f(kraw[t]), a = bf2f(araw[t]), r = bf2f(rraw[t]), ew = (float)eraw[t];
                const float kk = k * kkc * rsqrtf(fmaxf(*(LAS const float*)(sl + SC_X + t * 4), 1e-24f));
                const float kp = k * (1.f + (a - 1.f) * kac);
                const float at = -kk * W;
                W *= __expf(-ew);
                const float rt = r * W, iw = __builtin_amdgcn_rcpf(W);
                const unsigned wbk = pk_bf16(kk * a * iw, kp * iw), war = pk_bf16(at, rt);
                const bf16_t bh = (bf16_t)(wbk & 0xffffu), kh = (bf16_t)(wbk >> 16), ah = (bf16_t)(war & 0xffffu), rh = (bf16_t)(war >> 16);
                *(LAS bf16_t*)(sl + SC_AT + ((m * 16 + t) * 32 + pidx) * 2) = ah;
                *(LAS bf16_t*)(sl + SC_RT + ((m * 16 + t) * 32 + pidx) * 2) = rh;
                *(LAS bf16_t*)(sl + SC_BBT + (j * SC_BS + t) * 2) = bh;
                *(LAS bf16_t*)(sl + SC_KBT + (j * SC_BS + t) * 2) = kh;
                *(LAS bf16_t*)(sc + 0 + ((m * 16 + t) * 32 + pidx) * 2) = bh;
                *(LAS bf16_t*)(sc + 2048 + ((m * 16 + t) * 32 + pidx) * 2) = kh;
            }
            *(LAS float*)(sl + SC_WC + j * 4) = W;
#pragma unroll
            for (int q = 0; q < 4; ++q) *(LAS bf16_t*)(sl + SC_VP + (fr * 16 + 4 * fq + q) * 2) = vraw[q];
            if (cnext >= 0) pload(cnext);
            asm volatile("s_waitcnt lgkmcnt(0)" ::: "memory");
            f32x4 AB = (f32x4){0.f, 0.f, 0.f, 0.f}, AKm = AB, RBm = AB, RKm = AB;
#pragma unroll
            for (int kk2 = 0; kk2 < 2; ++kk2) {
                const int fo = ((kk2 * 16 + fr) * 32 + fq * 8) * 2;
                const bf16x8 fa = *(LAS const bf16x8*)(sl + SC_AT + fo), fr_ = *(LAS const bf16x8*)(sl + SC_RT + fo);
                const bf16x8 fb = *(LAS const bf16x8*)(sc + 0 + fo), fk = *(LAS const bf16x8*)(sc + 2048 + fo);
                AB = __builtin_amdgcn_mfma_f32_16x16x32_bf16(fa, fb, AB, 0, 0, 0); AKm = __builtin_amdgcn_mfma_f32_16x16x32_bf16(fa, fk, AKm, 0, 0, 0);
                RBm = __builtin_amdgcn_mfma_f32_16x16x32_bf16(fr_, fb, RBm, 0, 0, 0); RKm = __builtin_amdgcn_mfma_f32_16x16x32_bf16(fr_, fk, RKm, 0, 0, 0);
            }
#pragma unroll
            for (int r = 0; r < 4; ++r) { const int t = 4 * fq + r; const bool lo = fr < t, le = fr <= t;
                AB[r] = lo ? AB[r] : 0.f; AKm[r] = lo ? AKm[r] : 0.f; RBm[r] = le ? RBm[r] : 0.f; RKm[r] = le ? RKm[r] : 0.f; }
            asm volatile("s_waitcnt lgkmcnt(0)" ::: "memory");
            st_mat(sl + SC_AK, nullptr, nullptr, nullptr, AKm, fr, fq);
            st_mat(sl + SC_RB, nullptr, nullptr, nullptr, RBm, fr, fq);
            st_mat(sl + SC_RK, nullptr, nullptr, nullptr, RKm, fr, fq);
            LAS unsigned char* mL = sc, *mLT = sc + 512, *mIL = sc + 1024, *mL2 = sc + 1536, *mL2T = sc + 2048, *mIL2T = sc + 2560, *mL4 = sc + 3072, *mL4T = sc + 3584, *mIL4T = sc + 4096, *mIL8T = sc + 4608, *mP1 = sc + 5120, *mP2 = sc + 5632;
            st_mat(mL, mLT, nullptr, mIL, AB, fr, fq);
            const f32x4 L2 = mm16(mL, mLT, fr, fq);      st_mat(mL2, mL2T, mIL2T, nullptr, L2, fr, fq);
            const f32x4 L4 = mm16(mL2, mL2T, fr, fq);    const f32x4 P1 = mm16(mIL, mIL2T, fr, fq);
            st_mat(mL4, mL4T, mIL4T, nullptr, L4, fr, fq); st_mat(mP1, nullptr, nullptr, nullptr, P1, fr, fq);
            const f32x4 L8 = mm16(mL4, mL4T, fr, fq);    const f32x4 P2 = mm16(mP1, mIL4T, fr, fq);
            st_mat(nullptr, nullptr, mIL8T, nullptr, L8, fr, fq); st_mat(mP2, nullptr, nullptr, nullptr, P2, fr, fq);
            const f32x4 X = mm16(mP2, mIL8T, fr, fq);    st_mat(sl + SC_X, nullptr, nullptr, nullptr, X, fr, fq);
            asm volatile("s_waitcnt lgkmcnt(0)" ::: "memory");
        };
        f32x4 ST[4];
#pragma unroll
        for (int jt = 0; jt < 4; ++jt) ST[jt] = (f32x4){0.f, 0.f, 0.f, 0.f};
        auto consume = [&](int c, LAS const unsigned char* sl) {
            const bf16x8 s0 = __builtin_bit_cast(bf16x8, (u32x4){pk_bf16(ST[0][0], ST[0][1]), pk_bf16(ST[0][2], ST[0][3]), pk_bf16(ST[1][0], ST[1][1]), pk_bf16(ST[1][2], ST[1][3])});
            const bf16x8 s1 = __builtin_bit_cast(bf16x8, (u32x4){pk_bf16(ST[2][0], ST[2][1]), pk_bf16(ST[2][2], ST[2][3]), pk_bf16(ST[3][0], ST[3][1]), pk_bf16(ST[3][2], ST[3][3])});
            const bf16x8 at0 = *(LAS const bf16x8*)(sl + SC_AT + (fr * 32 + fq * 8) * 2), at1 = *(LAS const bf16x8*)(sl + SC_AT + ((16 + fr) * 32 + fq * 8) * 2);
            const bf16x8 rt0 = *(LAS const bf16x8*)(sl + SC_RT + (fr * 32 + fq * 8) * 2), rt1 = *(LAS const bf16x8*)(sl + SC_RT + ((16 + fr) * 32 + fq * 8) * 2);
            const int mo = (fr * 16 + 4 * fq) * 2;
            const bf16x8 vf = frag4(sl + SC_VP + mo), akf = frag4(sl + SC_AK + mo), xf = frag4(sl + SC_X + mo), rbf = frag4(sl + SC_RB + mo), rkf = frag4(sl + SC_RK + mo);
            const f32x4 z = (f32x4){0.f, 0.f, 0.f, 0.f};
            f32x4 g = __builtin_amdgcn_mfma_f32_16x16x32_bf16(at0, s0, z, 0, 0, 0);
            g = __builtin_amdgcn_mfma_f32_16x16x32_bf16(at1, s1, g, 0, 0, 0);
            g = __builtin_amdgcn_mfma_f32_16x16x32_bf16(akf, vf, g, 0, 0, 0);
            const f32x4 sa = __builtin_amdgcn_mfma_f32_16x16x32_bf16(xf, cfrag(g), z, 0, 0, 0);
            const bf16x8 saf = cfrag(sa);
            f32x4 y = __builtin_amdgcn_mfma_f32_16x16x32_bf16(rt0, s0, z, 0, 0, 0);
            y = __builtin_amdgcn_mfma_f32_16x16x32_bf16(rt1, s1, y, 0, 0, 0);
            y = __builtin_amdgcn_mfma_f32_16x16x32_bf16(rbf, saf, y, 0, 0, 0);
            y = __builtin_amdgcn_mfma_f32_16x16x32_bf16(rkf, vf, y, 0, 0, 0);
#pragma unroll
            for (int jt = 0; jt < 4; ++jt) {
                const f32x4 wc = *(LAS const f32x4*)(sl + SC_WC + (16 * jt + 4 * fq) * 4);
                const bf16x8 bb = frag4(sl + SC_BBT + ((16 * jt + fr) * SC_BS + 4 * fq) * 2), kb = frag4(sl + SC_KBT + ((16 * jt + fr) * SC_BS + 4 * fq) * 2);
                f32x4 acc = ST[jt];
                acc = __builtin_amdgcn_mfma_f32_16x16x32_bf16(bb, saf, acc, 0, 0, 0);
                acc = __builtin_amdgcn_mfma_f32_16x16x32_bf16(kb, vf, acc, 0, 0, 0);
                ST[jt] = acc * wc;
            }
#pragma unroll
            for (int r = 0; r < 4; ++r) Y[(tok0 + (size_t)c * 16 + 4 * fq + r) * 512 + h * 64 + rg * 16 + fr] = bf1(y[r]);
        };
        LAS unsigned char* scr = lds + SC_RING + (pw < 0 ? 0 : pw) * SC_SCR;
        if (wid >= 3) { pload(pw); pbuild(pw, lds + pw * SC_SLOT, scr, SC_NP + pw); }
        lds_barrier();
        for (int rd = 0; rd < NRD; ++rd) {
            if (wid == 0) {
#pragma unroll 1
                for (int q = 0; q < SC_NP; ++q) { const int c = rd * SC_NP + q; if (c < NCH) consume(c, lds + ((rd & 1) * SC_NP + q) * SC_SLOT); }
            } else if (wid >= 3) {
                const int cb = (rd + 1) * SC_NP + pw, cn = cb + SC_NP;
                if (cb < NCH) pbuild(cb, lds + (((rd + 1) & 1) * SC_NP + pw) * SC_SLOT, scr, cn < NCH ? cn : -1);
            }
            lds_barrier();
        }
        __syncthreads();
    }
}

__device__ __forceinline__ void phase_attn(const Params& p, int l, LAS unsigned char* ldsb) {
    unsigned char* R = p.ws + WS_R;
    const bf16_t* QKV = (const bf16_t*)(R + R_QKV); bf16_t* ATT = (bf16_t*)(R + R_ATT);
    const float* relb = p.in[7]; const float* sinks = p.in[8] + l * 8;
    const int tid = otid(), wid = tid >> 6, lane = tid & 63, fr = lane & 15, fq = lane >> 4;
    LAS bf16_t* Ks = (LAS bf16_t*)ldsb;
    LAS bf16_t* Vt = (LAS bf16_t*)(ldsb + 36864);
    LAS float* biasL = (LAS float*)(ldsb + 70656);
    LAS bf16_t* Pw = (LAS bf16_t*)(ldsb + 72704) + wid * (16 * 168);
    for (int item = obid(); item < 512; item += gridDim.x) {
        const int g = item & 1, n = (item >> 1) & 31, b = item >> 6;
        const long tokc = (long)b * SEQ + n * 128, tokp = tokc - 128;
        {
            u32x4 vq[4], kq[4];
#pragma unroll
            for (int q = 0; q < 4; ++q) { const int idx = tid + 512 * q, key = idx >> 3, d8 = idx & 7; vq[q] = (u32x4){0u, 0u, 0u, 0u}; kq[q] = vq[q];
                if (n > 0 || key >= 128) { const bf16_t* src = QKV + (size_t)(tokp + key) * 768 + 512 + g * 64 + d8 * 8; kq[q] = *(const u32x4*)src; vq[q] = *(const u32x4*)(src + 128); } }
#pragma unroll
            for (int q = 0; q < 4; ++q) { const int idx = tid + 512 * q, key = idx >> 3, d8 = idx & 7; const u32x4 v = vq[q];
                *(LAS u32x4*)(Ks + key * 72 + d8 * 8) = kq[q];
#pragma unroll
                for (int e = 0; e < 8; ++e) Vt[(d8 * 8 + e) * 264 + key] = (bf16_t)((e & 1) ? (v[e >> 1] >> 16) : (v[e >> 1] & 0xffffu)); }
        }
        { const int hl = tid >> 7, d = tid & 127; int bk = d;
          if (d >= 16) { bk = 16 + (int)(__logf((float)d * 0.0625f) * (16.f / 2.07944154168f)); bk = bk > 31 ? 31 : bk; }
          biasL[tid] = relb[bk * 8 + g * 4 + hl]; }
        __syncthreads();
        const int hl = wid >> 1, hq = g * 4 + hl; const float sink = sinks[hq];
        bf16x8 qn0, qn1; { const bf16_t* qp = QKV + (size_t)(tokc + (wid & 1) * 64 + fr) * 768 + hq * 64 + fq * 8; qn0 = *(const bf16x8*)qp; qn1 = *(const bf16x8*)(qp + 32); }
        for (int rt = 0; rt < 4; ++rt) {
            const int q0 = (wid & 1) * 64 + rt * 16, kstart = q0 < 96 ? q0 : 96;
            const bf16x8 qa0 = qn0, qa1 = qn1;
            { const int qn = (wid & 1) * 64 + (rt < 3 ? rt + 1 : rt) * 16;
              const bf16_t* qp = QKV + (size_t)(tokc + qn + fr) * 768 + hq * 64 + fq * 8; qn0 = *(const bf16x8*)qp; qn1 = *(const bf16x8*)(qp + 32); }
            f32x4 S[10];
#pragma unroll
            for (int kt = 0; kt < 10; ++kt) {
                LAS const bf16_t* kp = Ks + (kstart + kt * 16 + fr) * 72 + fq * 8;
                const bf16x8 k0 = *(LAS const bf16x8*)kp, k1 = *(LAS const bf16x8*)(kp + 32);
                f32x4 z = (f32x4){0.f, 0.f, 0.f, 0.f};
                z = __builtin_amdgcn_mfma_f32_16x16x32_bf16(qa0, k0, z, 0, 0, 0);
                z = __builtin_amdgcn_mfma_f32_16x16x32_bf16(qa1, k1, z, 0, 0, 0);
                S[kt] = z;
            }
            float mx[4] = {-INFINITY, -INFINITY, -INFINITY, -INFINITY};
#pragma unroll
            for (int kt = 0; kt < 10; ++kt)
#pragma unroll
                for (int j = 0; j < 4; ++j) {
                    const int key = kstart + kt * 16 + fr, dist = q0 + 4 * fq + j + 128 - key;
                    const bool ok = (dist >= 0) && (dist < 128) && (n > 0 || key >= 128);
                    const float s = ok ? (S[kt][j] * 0.125f + biasL[hl * 128 + (dist & 127)]) : -INFINITY;
                    S[kt][j] = s; mx[j] = fmaxf(mx[j], s);
                }
            float inv[4];
#pragma unroll
            for (int j = 0; j < 4; ++j) mx[j] = fmaxf(row16_max(mx[j]), sink);
            float sm[4] = {0.f, 0.f, 0.f, 0.f};
#pragma unroll
            for (int kt = 0; kt < 10; ++kt)
#pragma unroll
                for (int j = 0; j < 4; ++j) { const float e = __expf(S[kt][j] - mx[j]); S[kt][j] = e; sm[j] += e; }
#pragma unroll
            for (int j = 0; j < 4; ++j) inv[j] = 1.f / (row16_sum(sm[j]) + __expf(sink - mx[j]));
#pragma unroll
            for (int kt = 0; kt < 10; ++kt)
#pragma unroll
                for (int j = 0; j < 4; ++j) Pw[(4 * fq + j) * 168 + kt * 16 + fr] = (bf16_t)(pk_bf16(S[kt][j] * inv[j], 0.f) & 0xffffu);
            asm volatile("s_waitcnt lgkmcnt(0)" ::: "memory");
            __builtin_amdgcn_wave_barrier();
            f32x4 O[4];
#pragma unroll
            for (int dt = 0; dt < 4; ++dt) O[dt] = (f32x4){0.f, 0.f, 0.f, 0.f};
#pragma unroll
            for (int kk = 0; kk < 5; ++kk) {
                const bf16x8 pa = *(LAS const bf16x8*)(Pw + fr * 168 + kk * 32 + fq * 8);
#pragma unroll
                for (int dt = 0; dt < 4; ++dt) {
                    const bf16x8 vb = *(LAS const bf16x8*)(Vt + (dt * 16 + fr) * 264 + kstart + kk * 32 + fq * 8);
                    O[dt] = __builtin_amdgcn_mfma_f32_16x16x32_bf16(pa, vb, O[dt], 0, 0, 0);
                }
            }
#pragma unroll
            for (int dt = 0; dt < 4; ++dt)
#pragma unroll
                for (int j = 0; j < 4; ++j) ATT[(size_t)(tokc + q0 + 4 * fq + j) * 512 + hq * 64 + dt * 16 + fr] = (bf16_t)(pk_bf16(O[dt][j], 0.f) & 0xffffu);
            asm volatile("s_waitcnt lgkmcnt(0)" ::: "memory");
            __builtin_amdgcn_wave_barrier();
        }
        __syncthreads();
    }
}

__device__ __forceinline__ void phase_post(const Params& p, int l) {
    unsigned char* R = p.ws + WS_R;
    bf16_t* Y = (bf16_t*)(R + R_Y); const bf16_t* Vb = (const bf16_t*)(R + (l == 0 ? R_V : R_VNEW)); const bf16_t* G = (const bf16_t*)(R + R_G); const float* CB = (const float*)(R + R_CB);
    const float* gng = p.in[18] + (size_t)l * 512; const float* gnb = p.in[19] + (size_t)l * 512;
    const size_t total = (size_t)M_TOK * 64, nth = (size_t)gridDim.x * 512;
    const size_t it0 = (size_t)obid() * 512 + otid();
    const int c0 = (int)(it0 & 63) * 8, h = c0 >> 6;
    const f32x4 gg0 = *(const f32x4*)(gng + c0), gg1 = *(const f32x4*)(gng + c0 + 4), gb0 = *(const f32x4*)(gnb + c0), gb1 = *(const f32x4*)(gnb + c0 + 4);
    for (size_t it = it0; it < total; it += 2 * nth) {
        u32x4 yw[2], vw[2], gw[2]; float cb[2]; size_t row[2]; bool ok[2];
#pragma unroll
        for (int u = 0; u < 2; ++u) { const size_t iu = it + u * nth; ok[u] = iu < total; row[u] = (ok[u] ? iu : it) >> 6;
            yw[u] = *(const u32x4*)(Y + row[u] * 512 + c0); vw[u] = *(const u32x4*)(Vb + row[u] * 512 + c0); gw[u] = *(const u32x4*)(G + row[u] * 512 + c0); cb[u] = CB[row[u] * 8 + h]; }
#pragma unroll
        for (int u = 0; u < 2; ++u) {
            f32x4 y0, y1; unpack8(yw[u], y0, y1);
            float s = y0[0] + y0[1] + y0[2] + y0[3] + y1[0] + y1[1] + y1[2] + y1[3];
            s += dpp_f<0xB1>(s); s += dpp_f<0x4E>(s); s += dpp_f<0x141>(s);
            const float mu = s * (1.f / 64.f);
            y0 -= mu; y1 -= mu;
            float q = y0[0] * y0[0] + y0[1] * y0[1] + y0[2] * y0[2] + y0[3] * y0[3] + y1[0] * y1[0] + y1[1] * y1[1] + y1[2] * y1[2] + y1[3] * y1[3];
            q += dpp_f<0xB1>(q); q += dpp_f<0x4E>(q); q += dpp_f<0x141>(q);
            const float rs = rsqrtf(q * (1.f / 64.f) + 64e-5f);
            f32x4 v0, v1, g0, g1; unpack8(vw[u], v0, v1); unpack8(gw[u], g0, g1);
            const f32x4 o0 = (y0 * rs * gg0 + gb0 + v0 * cb[u]) * g0, o1 = (y1 * rs * gg1 + gb1 + v1 * cb[u]) * g1;
            if (ok[u]) *(u32x4*)(Y + row[u] * 512 + c0) = pack8(o0, o1);
        }
    }
}


#define XB_TMO      128
#define XB_XCNT(j)  (256  + 64 * (j))
#define XB_XSUB(j)  (1280 + 64 * (j))
#define XB_XGEN(j)  (2304 + 64 * (j))
#define XB_TOP      3328
#define XB_TOPGEN   3392
#define XCD_BAR_WORDS 3456
#define XB_SPIN_CAP (1u << 20)
__device__ __forceinline__ unsigned xb_ld(unsigned* p)              { return __hip_atomic_load(p, __ATOMIC_RELAXED, __HIP_MEMORY_SCOPE_AGENT); }
__device__ __forceinline__ unsigned xb_add(unsigned* p, unsigned v) { return __hip_atomic_fetch_add(p, v, __ATOMIC_RELAXED, __HIP_MEMORY_SCOPE_AGENT); }
__device__ __forceinline__ unsigned xb_xcc_id() { return (unsigned)__builtin_amdgcn_s_getreg((3 << 11) | 20) & 0xFu; }
#define XB_SPIN(cond, bar) do { unsigned _sp = 0; while (cond) { __builtin_amdgcn_s_sleep(1); \
    if ((++_sp & 255u) == 0u) { if (xb_ld(&(bar)[XB_TMO])) break; if (_sp > XB_SPIN_CAP) { atomicAdd(&(bar)[XB_TMO], 1u); break; } } } } while (0)
struct XcdBarrier { unsigned* bar; unsigned x; volatile LAS unsigned* st; };
__device__ __forceinline__ XcdBarrier xcd_barrier_post(unsigned* bar, volatile LAS unsigned* st) {
    XcdBarrier b; b.bar = bar; b.x = xb_xcc_id(); b.st = st;
    if (threadIdx.x == 0) (void)xb_add(&bar[XB_XCNT(b.x)], 1u);
    return b;
}
__device__ __forceinline__ void xcd_barrier_complete(unsigned* bar, unsigned x, unsigned& nloc, unsigned& nx) {
    const unsigned G = gridDim.x * gridDim.y * gridDim.z;
    unsigned sum, cnt, mine, sp = 0u;
    for (;;) {
        sum = 0u; cnt = 0u; mine = 0u;
#pragma unroll
        for (unsigned j = 0; j < 16; ++j) { const unsigned c = xb_ld(&bar[XB_XCNT(j)]); sum += c; cnt += (c > 0u) ? 1u : 0u; mine = (j == x) ? c : mine; }
        if (sum == G) break;
        __builtin_amdgcn_s_sleep(1);
        if ((++sp & 255u) == 0u) { if (xb_ld(&bar[XB_TMO])) break; if (sp > XB_SPIN_CAP) { atomicAdd(&bar[XB_TMO], 1u); break; } }
    }
    nloc = mine > 0u ? mine : 1u; nx = cnt > 0u ? cnt : 1u;
}
__device__ __forceinline__ void xcd_barrier(const XcdBarrier& b) {
    asm volatile("s_waitcnt vmcnt(0)" ::: "memory");
    __syncthreads();
    if (threadIdx.x == 0) {
        unsigned* bar = b.bar;
        __builtin_amdgcn_s_waitcnt(0);
        unsigned nloc = b.st[0], nx = b.st[1];
        if (nloc == 0u) { xcd_barrier_complete(bar, b.x, nloc, nx); b.st[0] = nloc; b.st[1] = nx; }
        const unsigned old = xb_add(&bar[XB_XSUB(b.x)], 1u);
        const unsigned gen = old / nloc;
        if (old + 1u == (gen + 1u) * nloc) {
            __builtin_amdgcn_fence(__ATOMIC_RELEASE, "agent");
            asm volatile("s_waitcnt vmcnt(0)" ::: "memory");
            const unsigned og = xb_add(&bar[XB_TOP], 1u);
            const unsigned tg = og / nx;
            if (og + 1u == (tg + 1u) * nx) xb_add(&bar[XB_TOPGEN], 1u);
            else XB_SPIN(xb_ld(&bar[XB_TOPGEN]) == tg, bar);
            __builtin_amdgcn_fence(__ATOMIC_ACQUIRE, "agent");
            xb_add(&bar[XB_XGEN(b.x)], 1u);
            asm volatile("s_waitcnt vmcnt(0)" ::: "memory");
        } else {
            XB_SPIN(xb_ld(&bar[XB_XGEN(b.x)]) == gen, bar);
            __builtin_amdgcn_fence(__ATOMIC_ACQUIRE, "agent");
            asm volatile("s_waitcnt vmcnt(0)" ::: "memory");
        }
    }
    __syncthreads();
}

__device__ __forceinline__ void gsync(cg::grid_group& grid) {
    asm volatile("s_waitcnt vmcnt(0) lgkmcnt(0)" ::: "memory");
    grid.sync();
    __builtin_amdgcn_fence(__ATOMIC_ACQUIRE, "agent");
    asm volatile("s_waitcnt vmcnt(0)" ::: "memory");
}
__global__ void __launch_bounds__(512, 2) fwd_kernel(Params p) {
    extern __shared__ __attribute__((aligned(16))) unsigned char shm[];
    LAS unsigned char* lds = (LAS unsigned char*)shm;
    cg::grid_group grid = cg::this_grid();
    unsigned char* R = p.ws + WS_R;
    const bf16_t* WB = (const bf16_t*)(p.ws + WS_WB);
    bf16_t* XB = (bf16_t*)(p.ws + WS_XB);

    volatile LAS unsigned* xst = (volatile LAS unsigned*)(lds + LDS_XB);
    if (threadIdx.x == 0) { xst[0] = 0u; xst[1] = 0u; }
    __syncthreads();
    const XcdBarrier xb = xcd_barrier_post((unsigned*)(p.ws + WS_BAR), xst);
    phase_cvt_x(p);
    phase_wprep(p, 0, (LAS float*)lds);
    gsync(grid);
#pragma unroll 1
    for (int hs = 0; hs < 4; ++hs) {
        const int l = hs >> 1, j = hs & 1;
        { Gemm g; g.A = XB; g.Bt = WB + (j ? WB_GU1 : WB_GU0); g.M = M_TOK; g.N = 5632; g.K = 1024;
          EpiGU e; e.H = (bf16_t*)(R + R_HB); gemm_phase(lds, g, e); }
        xcd_barrier(xb);
        { Gemm g; g.A = (const bf16_t*)(R + R_HB); g.Bt = WB + (j ? WB_D1 : WB_D0); g.M = M_TOK; g.N = 1024; g.K = 2816;
          EpiP<FDelta> e; e.f.D = (bf16_t*)(R + R_DEL); e.f.beta = 0.5f; gemm_phase(lds, g, e); }
        xcd_barrier(xb);
        { const int li = l * 3 + (j ? 2 : 0); phase_ln((hs == 0) ? p.in[0] : p.out, (const bf16_t*)(R + R_DEL), p.out, XB, p.in[3] + (size_t)li * 1024, p.in[4] + (size_t)li * 1024, hs != 3); }
        if (hs == 1) phase_wprep(p, 1, (LAS float*)lds);
        xcd_barrier(xb);
        if (j == 0) {
            { Gemm g; g.A = XB; g.Bt = WB + WB_IN + (size_t)2048 * 1024; g.M = M_TOK; g.N = 2560; g.K = 1024;
              EpiP<FProj> e; e.f.QKV = (bf16_t*)(R + R_QKV); e.f.U = (bf16_t*)(R + R_U); e.f.bias = p.in[6] + (size_t)l * 4608 + 2048; gemm_phase(lds, g, e); }
            xcd_barrier(xb);
            phase_prep(p, l);
            xcd_barrier(xb);
            { Gemm g; g.A = (const bf16_t*)(R + R_AP); g.Bt = WB + WB_LR; g.M = M_TOK; g.N = 1536; g.K = 256;
              EpiP<FLowRank> e; e.f.EW = (_Float16*)(R + R_EW); e.f.A = (bf16_t*)(R + R_A); e.f.G = (bf16_t*)(R + R_G); e.f.w0 = p.in[10] + (size_t)l * 512; e.f.a0 = p.in[12] + (size_t)l * 512;
              gemm_phase(lds, g, e); }
            if (l >= 1) {
                Gemm g; g.A = (const bf16_t*)(R + R_V); g.Bt = WB + WB_V12; g.M = M_TOK; g.N = 512; g.K = 512;
                EpiP<FVmix> e; e.f.V = (const bf16_t*)(R + R_V); e.f.VF = (const bf16_t*)(p.ws + WS_VF); e.f.VN = (bf16_t*)(R + R_VNEW); e.f.v0p = p.in[20] + (size_t)(l - 1) * 512;
                gemm_phase(lds, g, e);
            }
            xcd_barrier(xb);
            phase_scan2(p, l, lds);
            phase_attn(p, l, lds);
            xcd_barrier(xb);
            phase_post(p, l);
            { Gemm g; g.A = XB; g.Bt = WB + WB_IN; g.M = M_TOK; g.N = 2048; g.K = 1024;
              EpiP<FGates> e; e.f.GA = (bf16_t*)(R + R_GA); e.f.GB = (bf16_t*)(R + R_GB); e.f.bias = p.in[6] + (size_t)l * 4608; gemm_phase(lds, g, e); }
            xcd_barrier(xb);
            { Gemm g; g.A = (const bf16_t*)(R + R_ATT); g.Bt = WB + WB_BA; g.M = M_TOK; g.N = 1024; g.K = 512;
              EpiP<FBranch<false>> e; e.f.GT = (const bf16_t*)(R + R_GA); e.f.MB = (bf16_t*)(R + R_MB); gemm_phase(lds, g, e); }
            asm volatile("s_waitcnt vmcnt(0)" ::: "memory");
            { Gemm g; g.A = (const bf16_t*)(R + R_Y); g.Bt = WB + WB_BB; g.M = M_TOK; g.N = 1024; g.K = 512;
              EpiP<FBranch<true>> e; e.f.GT = (const bf16_t*)(R + R_GB); e.f.MB = (bf16_t*)(R + R_MB); gemm_phase(lds, g, e); }
            xcd_barrier(xb);
            { Gemm g; g.A = (const bf16_t*)(R + R_MB); g.Bt = WB + WB_O; g.M = M_TOK; g.N = 1024; g.K = 1024;
              EpiP<FDelta> e; e.f.D = (bf16_t*)(R + R_DEL); e.f.beta = 1.0f; gemm_phase(lds, g, e); }
            xcd_barrier(xb);
            { const int li = l * 3 + 1; phase_ln(p.out, (const bf16_t*)(R + R_DEL), p.out, XB, p.in[3] + (size_t)li * 1024, p.in[4] + (size_t)li * 1024, true); }
            xcd_barrier(xb);
        }
    }
}

extern "C" void kernel_launch(void* const* d_in, const int* in_sizes, int n_in, void* d_out, int out_size, void* d_ws, size_t ws_size, hipStream_t stream) {
    static int grid = 0;
    if (grid == 0) {
        if (n_in != 26 || ws_size < WS_END) { grid = -1; return; }
        int dev = 0, cus = 0, per_cu = 0;
        (void)hipGetDevice(&dev);
        (void)hipDeviceGetAttribute(&cus, hipDeviceAttributeMultiprocessorCount, dev);
        (void)hipFuncSetAttribute((const void*)fwd_kernel, hipFuncAttributeMaxDynamicSharedMemorySize, LDS_BYTES);
        if (hipOccupancyMaxActiveBlocksPerMultiprocessor(&per_cu, (const void*)fwd_kernel, 512, LDS_BYTES) != hipSuccess || per_cu < 1) per_cu = 1;
        (void)hipGetLastError();
        grid = cus * 1;
        if (grid <= 0) grid = 256;
    }
    if (grid < 0) return;
    (void)hipMemsetAsync((unsigned char*)d_ws + WS_BAR, 0, XCD_BAR_WORDS * sizeof(unsigned), stream);
    Params p{};
    for (int i = 0; i < 26; ++i) p.in[i] = (const float*)d_in[i];
    p.out = (float*)d_out; p.ws = (unsigned char*)d_ws;
    void* args[] = {&p};
    (void)hipLaunchCooperativeKernel((const void*)fwd_kernel, dim3(grid), dim3(512), args, LDS_BYTES, stream);
}
```
